# Optimizing an MI355X kernel written in HIP

```python
import jax, jax.numpy as jnp
from jax import lax
import numpy as np

D_MODEL = 1024
BATCH = 8
SEQ = 4096
DEPTH = 1

PLE_DIM = 256
RMS_EPS = 1e-6
MACARON = 0.5
FFN_HIDDEN = 2816
ATT_HEADS = 8
ATT_KV_HEADS = 2
ATT_HEAD_DIM = 64
ATT_WINDOW = 128
ATT_BLOCK = 128
ROPE_THETA = 500000.0
ROPE_DIM = ATT_HEAD_DIM // 4
MLSTM_HEADS = 4
MLSTM_QK_DIM = 128
MLSTM_V_DIM = 256
MLSTM_CHUNK = 64
MLSTM_CONV = 5
ATT_Q_W = ATT_HEADS * ATT_HEAD_DIM
ATT_KV_W = ATT_KV_HEADS * ATT_HEAD_DIM
M_QK_W = MLSTM_HEADS * MLSTM_QK_DIM
M_V_W = MLSTM_HEADS * MLSTM_V_DIM
M_GATE_W = 4 * MLSTM_HEADS
MERGE_W = 2 * D_MODEL
IN_SIZES = (ATT_Q_W, ATT_KV_W, ATT_KV_W, M_QK_W, M_QK_W, M_V_W, M_V_W, M_GATE_W, MERGE_W)
IN_WIDTH = ATT_Q_W + 2 * ATT_KV_W + 2 * M_QK_W + 2 * M_V_W + M_GATE_W + MERGE_W

kernel_name = 'hybrid_swa_mlstm_macaron_encoder'


def rms_norm(x, g):
    xf = x.astype(jnp.float32)
    y = xf * lax.rsqrt(jnp.mean(xf * xf, axis=-1, keepdims=True) + RMS_EPS)
    return (y * g.astype(jnp.float32)).astype(x.dtype)


def swiglu(x, w1, w2):
    z = x @ w1
    return (jax.nn.silu(z[..., :FFN_HIDDEN]) * z[..., FFN_HIDDEN:]) @ w2


def split_cols(z, sizes):
    outs = []
    off = 0
    for s in sizes:
        outs.append(z[..., off:off + s])
        off += s
    return outs


def rope_tables(seq):
    pos = jnp.arange(seq, dtype=jnp.float32)
    inv = ROPE_THETA ** (-jnp.arange(0, ROPE_DIM, 2, dtype=jnp.float32) / ROPE_DIM)
    ang = pos[:, None] * inv[None, :]
    return jnp.cos(ang)[:, None, :], jnp.sin(ang)[:, None, :]


def partial_rope(x, cos, sin):
    half = ROPE_DIM // 2
    xr = x[..., :ROPE_DIM].astype(jnp.float32)
    x1, x2 = xr[..., :half], xr[..., half:]
    rot = jnp.concatenate([x1 * cos - x2 * sin, x2 * cos + x1 * sin], axis=-1)
    return jnp.concatenate([rot.astype(x.dtype), x[..., ROPE_DIM:]], axis=-1)


def windowed_gqa(q, k, v, sink):
    b, s, hq, dh = q.shape
    g = hq // ATT_KV_HEADS
    blk = ATT_BLOCK
    nb = s // blk
    pad = ((0, 0), (blk, blk), (0, 0), (0, 0))
    kb = jnp.pad(k, pad).reshape(b, nb + 2, blk, ATT_KV_HEADS, dh)
    vb = jnp.pad(v, pad).reshape(b, nb + 2, blk, ATT_KV_HEADS, dh)
    kw = jnp.concatenate([kb[:, :-2], kb[:, 1:-1], kb[:, 2:]], axis=2)
    vw = jnp.concatenate([vb[:, :-2], vb[:, 1:-1], vb[:, 2:]], axis=2)
    qb = q.reshape(b, nb, blk, ATT_KV_HEADS, g, dh)
    sc = jnp.einsum('bnqhgd,bnkhd->bnhgqk', qb, kw).astype(jnp.float32) * (dh ** -0.5)
    qi = jnp.arange(blk)[:, None]
    kc = jnp.arange(3 * blk)[None, :]
    rel = kc - blk - qi
    kpos = jnp.arange(nb)[:, None, None] * blk - blk + kc[None]
    mask = (jnp.abs(rel) <= ATT_WINDOW)[None] & (kpos >= 0) & (kpos < s)
    sc = jnp.where(mask[None, :, None, None], sc, -jnp.inf)
    sk = sink.astype(jnp.float32).reshape(1, 1, ATT_KV_HEADS, g, 1, 1)
    mx = jnp.maximum(jnp.max(sc, axis=-1, keepdims=True), sk)
    pr = jnp.exp(sc - mx)
    pr = pr / (jnp.sum(pr, axis=-1, keepdims=True) + jnp.exp(sk - mx))
    o = jnp.einsum('bnhgqk,bnkhd->bnqhgd', pr.astype(v.dtype), vw)
    return o.reshape(b, s, hq * dh)


def centred_depthwise_conv(x, w, bias):
    c = x.shape[-1]
    y = lax.conv_general_dilated(
        x, w[:, None, :].astype(x.dtype), window_strides=(1,),
        padding=((MLSTM_CONV // 2, MLSTM_CONV // 2),),
        dimension_numbers=('NWC', 'WIO', 'NWC'), feature_group_count=c)
    return y + bias


def mlstm_chunkwise(q, k, v, log_i, log_f):
    n, s, h, dk = q.shape
    dv = v.shape[-1]
    L = MLSTM_CHUNK
    nc = s // L

    def to_chunks(t):
        return jnp.moveaxis(t.reshape((n, nc, L, h) + t.shape[3:]), (1, 3), (0, 2))

    xs = (to_chunks(q), to_chunks(k), to_chunks(v), to_chunks(log_i), to_chunks(log_f))
    tril = jnp.tril(jnp.ones((L, L), dtype=bool))

    def step(carry, inp):
        c_mat, n_vec, m_prev = carry
        qc, kc, vc, li, lf = inp
        b = jnp.cumsum(lf, axis=-1)
        d_log = jnp.where(tril, b[..., :, None] - b[..., None, :] + li[..., None, :], -jnp.inf)
        inter = b + m_prev[..., None]
        m_row = jnp.maximum(inter, jnp.max(d_log, axis=-1))
        w_intra = jnp.exp(d_log - m_row[..., None])
        w_inter = jnp.exp(inter - m_row)
        sc = jnp.einsum('nhjd,nhtd->nhjt', qc, kc) * w_intra
        num = jnp.einsum('nhjt,nhtv->nhjv', sc, vc) + w_inter[..., None] * jnp.einsum('nhjd,nhdv->nhjv', qc, c_mat)
        den = jnp.sum(sc, axis=-1) + w_inter * jnp.einsum('nhjd,nhd->nhj', qc, n_vec)
        h_out = num / jnp.maximum(jnp.abs(den), jnp.exp(-m_row))[..., None]
        b_last = b[..., -1]
        k_log = b_last[..., None] - b + li
        m_new = jnp.maximum(b_last + m_prev, jnp.max(k_log, axis=-1))
        w_k = jnp.exp(k_log - m_new[..., None])
        decay = jnp.exp(b_last + m_prev - m_new)
        c_new = decay[..., None, None] * c_mat + jnp.einsum('nht,nhtd,nhtv->nhdv', w_k, kc, vc)
        n_new = decay[..., None] * n_vec + jnp.einsum('nht,nhtd->nhd', w_k, kc)
        return (c_new, n_new, m_new), h_out

    init = (jnp.zeros((n, h, dk, dv), jnp.float32), jnp.zeros((n, h, dk), jnp.float32), jnp.zeros((n, h), jnp.float32))
    _, hs = lax.scan(step, init, xs)
    return jnp.moveaxis(hs, (0, 2), (1, 3)).reshape(n, s, h, dv)


def mlstm_bidirectional(q, k, v, li_fw, lf_fw, li_bw, lf_bw):
    nb = q.shape[0]

    def both(a, c):
        return jnp.concatenate([a, jnp.flip(c, axis=1)], axis=0)

    hs = mlstm_chunkwise(both(q, q), both(k, k), both(v, v), both(li_fw, li_bw), both(lf_fw, lf_bw))
    return hs[:nb] + jnp.flip(hs[nb:], axis=1)


def token_mixer(u, w_in, b_gates, conv_w, conv_b, attn_sink, mlstm_norm, w_branch_attn, w_branch_mlstm, w_out):
    bsz, s, _ = u.shape
    z = u @ w_in
    aq, ak, av, mq, mk, mv, mo, mg, bg = split_cols(z, IN_SIZES)
    cos, sin = rope_tables(s)
    aq = partial_rope(aq.reshape(bsz, s, ATT_HEADS, ATT_HEAD_DIM), cos, sin)
    ak = partial_rope(ak.reshape(bsz, s, ATT_KV_HEADS, ATT_HEAD_DIM), cos, sin)
    av = av.reshape(bsz, s, ATT_KV_HEADS, ATT_HEAD_DIM)
    ya = windowed_gqa(aq, ak, av, attn_sink) @ w_branch_attn
    mqk = jax.nn.silu(centred_depthwise_conv(jnp.concatenate([mq, mk], axis=-1), conv_w, conv_b))
    mq = mqk[..., :M_QK_W].reshape(bsz, s, MLSTM_HEADS, MLSTM_QK_DIM)
    mk = mqk[..., M_QK_W:].reshape(bsz, s, MLSTM_HEADS, MLSTM_QK_DIM) * (MLSTM_QK_DIM ** -0.5)
    mv = mv.reshape(bsz, s, MLSTM_HEADS, MLSTM_V_DIM)
    gates = (mg + b_gates).astype(jnp.float32).reshape(bsz, s, 4, MLSTM_HEADS)
    li_fw = gates[:, :, 0]
    lf_fw = jax.nn.log_sigmoid(gates[:, :, 1])
    li_bw = gates[:, :, 2]
    lf_bw = jax.nn.log_sigmoid(gates[:, :, 3])
    hm = mlstm_bidirectional(mq, mk, mv, li_fw, lf_fw, li_bw, lf_bw)
    hm = hm * lax.rsqrt(jnp.mean(hm * hm, axis=-1, keepdims=True) + RMS_EPS)
    hm = hm * mlstm_norm.astype(jnp.float32).reshape(MLSTM_HEADS, MLSTM_V_DIM)
    hm = (hm.reshape(bsz, s, M_V_W) * jax.nn.sigmoid(mo.astype(jnp.float32))).astype(u.dtype)
    ym = hm @ w_branch_mlstm
    merged = jax.nn.sigmoid(bg[..., :D_MODEL]) * ya + jax.nn.sigmoid(bg[..., D_MODEL:]) * ym
    return merged @ w_out


def setup_inputs(seed: int = 0) -> dict:
    key = jax.random.key(seed)
    ks = jax.random.split(key, 25)
    f32 = jnp.float32

    def w(k, shape, fan_in):
        return jax.random.normal(k, shape, f32) * (fan_in ** -0.5)

    def gain(k, width):
        return 1.0 + 0.05 * jax.random.normal(k, (DEPTH, width), f32)

    f_off = jnp.linspace(3.0, 6.0, MLSTM_HEADS)
    i_off = jnp.zeros((MLSTM_HEADS,), f32)
    gate_off = jnp.stack([i_off, f_off, i_off, f_off])
    b_gates = (0.1 * jax.random.normal(ks[8], (DEPTH, 4, MLSTM_HEADS), f32) + gate_off[None]).reshape(DEPTH, M_GATE_W)
    return {
        'x': jax.random.normal(ks[0], (BATCH, SEQ, D_MODEL), f32),
        'p': jax.random.normal(ks[1], (DEPTH, BATCH, SEQ, PLE_DIM), f32),
        'ffn1_norm_pre': gain(ks[2], D_MODEL),
        'ffn1_w1': w(ks[3], (DEPTH, D_MODEL, 2 * FFN_HIDDEN), D_MODEL),
        'ffn1_w2': w(ks[4], (DEPTH, FFN_HIDDEN, D_MODEL), FFN_HIDDEN),
        'ffn1_norm_post': gain(ks[5], D_MODEL),
        'mix_norm_pre': gain(ks[6], D_MODEL),
        'w_in': w(ks[7], (DEPTH, D_MODEL, IN_WIDTH), D_MODEL),
        'b_gates': b_gates,
        'conv_w': w(ks[9], (DEPTH, MLSTM_CONV, 2 * M_QK_W), MLSTM_CONV),
        'conv_b': 0.02 * jax.random.normal(ks[10], (DEPTH, 2 * M_QK_W), f32),
        'attn_sink': 0.5 * jax.random.normal(ks[11], (DEPTH, ATT_HEADS), f32),
        'mlstm_norm': gain(ks[12], M_V_W),
        'w_branch_attn': w(ks[13], (DEPTH, ATT_Q_W, D_MODEL), ATT_Q_W),
        'w_branch_mlstm': w(ks[14], (DEPTH, M_V_W, D_MODEL), M_V_W),
        'w_out': w(ks[15], (DEPTH, D_MODEL, D_MODEL), D_MODEL),
        'mix_norm_post': gain(ks[16], D_MODEL),
        'ffn2_norm_pre': gain(ks[17], D_MODEL),
        'ffn2_w1': w(ks[18], (DEPTH, D_MODEL, 2 * FFN_HIDDEN), D_MODEL),
        'ffn2_w2': w(ks[19], (DEPTH, FFN_HIDDEN, D_MODEL), FFN_HIDDEN),
        'ffn2_norm_post': gain(ks[20], D_MODEL),
        'ple_norm_pre': gain(ks[21], D_MODEL),
        'w_ple_gate': w(ks[22], (DEPTH, D_MODEL, D_MODEL), D_MODEL),
        'w_ple_proj': w(ks[23], (DEPTH, PLE_DIM, D_MODEL), PLE_DIM),
        'ple_norm_post': gain(ks[24], D_MODEL),
    }


def reference(x, p, ffn1_norm_pre, ffn1_w1, ffn1_w2, ffn1_norm_post, mix_norm_pre, w_in, b_gates, conv_w, conv_b,
              attn_sink, mlstm_norm, w_branch_attn, w_branch_mlstm, w_out, mix_norm_post, ffn2_norm_pre, ffn2_w1,
              ffn2_w2, ffn2_norm_post, ple_norm_pre, w_ple_gate, w_ple_proj, ple_norm_post):
    h = x
    for i in range(DEPTH):
        h = h + MACARON * rms_norm(swiglu(rms_norm(h, ffn1_norm_pre[i]), ffn1_w1[i], ffn1_w2[i]), ffn1_norm_post[i])
        mix = token_mixer(rms_norm(h, mix_norm_pre[i]), w_in[i], b_gates[i], conv_w[i], conv_b[i], attn_sink[i],
                          mlstm_norm[i], w_branch_attn[i], w_branch_mlstm[i], w_out[i])
        h = h + rms_norm(mix, mix_norm_post[i])
        h = h + MACARON * rms_norm(swiglu(rms_norm(h, ffn2_norm_pre[i]), ffn2_w1[i], ffn2_w2[i]), ffn2_norm_post[i])
        gate = jax.nn.sigmoid(rms_norm(h, ple_norm_pre[i]) @ w_ple_gate[i])
        h = h + rms_norm((p[i] @ w_ple_proj[i]) * gate, ple_norm_post[i])
    return h
```

```cpp
#include <hip/hip_runtime.h>
#include <cstdio>
#include <cstdint>

namespace {
constexpr int D = 1024, BATCH = 8, SEQ = 4096, PLE = 256, FFN = 2816;
constexpr int INW = 5904;
constexpr int O_AQ = 0, O_AK = 512, O_AV = 640, O_MQ = 768, O_MK = 1280, O_MV = 1792, O_MO = 2816, O_MG = 3840, O_BG = 3856;
constexpr float EPS = 1e-6f;

__device__ __forceinline__ float block_sum_256(float v, float* red) {
    for (int o = 32; o > 0; o >>= 1) v += __shfl_xor(v, o);
    const int w = threadIdx.x >> 6;
    __syncthreads();
    if ((threadIdx.x & 63) == 0) red[w] = v;
    __syncthreads();
    return red[0] + red[1] + red[2] + red[3];
}

__global__ void __launch_bounds__(256) k_rmsnorm(const float* in, const float* g, float* out) {
    __shared__ float red[4];
    const size_t row = blockIdx.x;
    const float* x = in + row * D;
    float v[4]; float s = 0.f;
    for (int j = 0; j < 4; ++j) { v[j] = x[threadIdx.x + 256 * j]; s += v[j] * v[j]; }
    s = block_sum_256(s, red);
    const float r = rsqrtf(s * (1.f / D) + EPS);
    for (int j = 0; j < 4; ++j) out[row * D + threadIdx.x + 256 * j] = v[j] * r * g[threadIdx.x + 256 * j];
}
__global__ void __launch_bounds__(256) k_resnorm(const float* hin, const float* y, const float* g, float scale, float* hout) {
    __shared__ float red[4];
    const size_t row = blockIdx.x;
    const float* x = y + row * D;
    float v[4]; float s = 0.f;
    for (int j = 0; j < 4; ++j) { v[j] = x[threadIdx.x + 256 * j]; s += v[j] * v[j]; }
    s = block_sum_256(s, red);
    const float r = rsqrtf(s * (1.f / D) + EPS);
    for (int j = 0; j < 4; ++j) { const int c = threadIdx.x + 256 * j; hout[row * D + c] = hin[row * D + c] + scale * v[j] * r * g[c]; }
}

__global__ void __launch_bounds__(256) k_gemm(const float* __restrict__ A, int lda, const float* __restrict__ B, int ldb, float* __restrict__ C, int ldc, int M, int N, int K) {
    __shared__ float As[16][64 + 4];
    __shared__ float Bs[16][64 + 4];
    const int tx = threadIdx.x & 15, ty = threadIdx.x >> 4;
    const int m0 = blockIdx.y * 64, n0 = blockIdx.x * 64;
    float acc[4][4] = {};
    for (int k0 = 0; k0 < K; k0 += 16) {
        for (int i = threadIdx.x; i < 64 * 16; i += 256) {
            const int r = i >> 4, c = i & 15;
            As[c][r] = A[(size_t)(m0 + r) * lda + k0 + c];
        }
        for (int i = threadIdx.x; i < 16 * 64; i += 256) {
            const int r = i >> 6, c = i & 63;
            Bs[r][c] = (n0 + c < N) ? B[(size_t)(k0 + r) * ldb + n0 + c] : 0.f;
        }
        __syncthreads();
#pragma unroll
        for (int kk = 0; kk < 16; ++kk) {
            float a[4], b[4];
#pragma unroll
            for (int i = 0; i < 4; ++i) { a[i] = As[kk][ty * 4 + i]; b[i] = Bs[kk][tx * 4 + i]; }
#pragma unroll
            for (int i = 0; i < 4; ++i)
#pragma unroll
                for (int j = 0; j < 4; ++j) acc[i][j] += a[i] * b[j];
        }
        __syncthreads();
    }
    for (int i = 0; i < 4; ++i)
        for (int j = 0; j < 4; ++j) { const int n = n0 + tx * 4 + j; if (n < N) C[(size_t)(m0 + ty * 4 + i) * ldc + n] = acc[i][j]; }
}

__device__ __forceinline__ float sigmoidf_(float x) { return 1.f / (1.f + expf(-x)); }
__device__ __forceinline__ float siluf_(float x) { return x * sigmoidf_(x); }
__device__ __forceinline__ float logsigmoidf_(float x) { return fminf(x, 0.f) - log1pf(expf(-fabsf(x))); }

__global__ void k_swiglu(const float* z, float* hid, int rows) {
    const size_t i = (size_t)blockIdx.x * blockDim.x + threadIdx.x;
    if (i >= (size_t)rows * FFN) return;
    const size_t r = i / FFN; const int c = (int)(i % FFN);
    hid[i] = siluf_(z[r * (2 * FFN) + c]) * z[r * (2 * FFN) + FFN + c];
}

__global__ void k_rope_tables(float* cs, float* sn) {
    const int i = blockIdx.x * blockDim.x + threadIdx.x;
    if (i >= SEQ * 8) return;
    const int pos = i >> 3, j = i & 7;
    const float inv = (float)pow(500000.0, -(double)j / 8.0);
    const float ang = (float)pos * inv;
    cs[i] = (float)cos((double)ang); sn[i] = (float)sin((double)ang);
}

__global__ void __launch_bounds__(64) k_attn(const float* z, const float* cs, const float* sn, const float* sink, float* out) {
    const int idx = blockIdx.x * 64 + threadIdx.x;
    const int s = idx >> 3, hq = idx & 7, kvh = hq >> 2;
    float q[64];
    const float* qp = z + (size_t)s * INW + O_AQ + hq * 64;
    for (int d = 0; d < 64; ++d) q[d] = qp[d];
    for (int j = 0; j < 8; ++j) { const float c = cs[s * 8 + j], sv = sn[s * 8 + j], x1 = q[j], x2 = q[j + 8]; q[j] = x1 * c - x2 * sv; q[j + 8] = x2 * c + x1 * sv; }
    const int k_lo = max(0, s - 128), k_hi = min(SEQ - 1, s + 128);
    const float sk = sink[hq];
    float mx = sk;
    for (int t = k_lo; t <= k_hi; ++t) {
        const float* kp = z + (size_t)t * INW + O_AK + kvh * 64;
        float acc = 0.f;
        for (int j = 0; j < 8; ++j) { const float c = cs[t * 8 + j], sv = sn[t * 8 + j], x1 = kp[j], x2 = kp[j + 8]; acc += q[j] * (x1 * c - x2 * sv) + q[j + 8] * (x2 * c + x1 * sv); }
        for (int d = 16; d < 64; ++d) acc += q[d] * kp[d];
        mx = fmaxf(mx, acc * 0.125f);
    }
    float o[64]; for (int d = 0; d < 64; ++d) o[d] = 0.f;
    float l = expf(sk - mx);
    for (int t = k_lo; t <= k_hi; ++t) {
        const float* kp = z + (size_t)t * INW + O_AK + kvh * 64;
        const float* vp = z + (size_t)t * INW + O_AV + kvh * 64;
        float acc = 0.f;
        for (int j = 0; j < 8; ++j) { const float c = cs[t * 8 + j], sv = sn[t * 8 + j], x1 = kp[j], x2 = kp[j + 8]; acc += q[j] * (x1 * c - x2 * sv) + q[j + 8] * (x2 * c + x1 * sv); }
        for (int d = 16; d < 64; ++d) acc += q[d] * kp[d];
        const float p = expf(acc * 0.125f - mx);
        l += p;
        for (int d = 0; d < 64; ++d) o[d] += p * vp[d];
    }
    const float il = 1.f / l;
    for (int d = 0; d < 64; ++d) out[(size_t)s * 512 + hq * 64 + d] = o[d] * il;
}

__global__ void k_conv(const float* z, const float* cw, const float* cb, float* cqk) {
    const size_t i = (size_t)blockIdx.x * blockDim.x + threadIdx.x;
    if (i >= (size_t)SEQ * 1024) return;
    const int s = (int)(i >> 10), c = (int)(i & 1023);
    float acc = cb[c];
    for (int j = 0; j < 5; ++j) { const int t = s + j - 2; if (t >= 0 && t < SEQ) acc += z[(size_t)t * INW + O_MQ + c] * cw[j * 1024 + c]; }
    float v = siluf_(acc);
    if (c >= 512) v *= 0.08838834764831845f;
    cqk[i] = v;
}

__global__ void __launch_bounds__(320) k_mlstm(const float* z, const float* cqk, const float* bg, float* hs  ) {
    __shared__ float qs[128], ks[128], den_s;
    const int h = blockIdx.x & 3, dir = blockIdx.x >> 2, tid = threadIdx.x;
    float C[128];
#pragma unroll
    for (int j = 0; j < 128; ++j) C[j] = 0.f;
    for (int st = 0; st < SEQ; ++st) {
        const int s = dir ? (SEQ - 1 - st) : st;
        __syncthreads();
        if (tid < 128) qs[tid] = cqk[(size_t)s * 1024 + h * 128 + tid];
        else if (tid < 256) ks[tid - 128] = cqk[(size_t)s * 1024 + 512 + h * 128 + (tid - 128)];
        const float li = z[(size_t)s * INW + O_MG + (dir * 2 + 0) * 4 + h] + bg[(dir * 2 + 0) * 4 + h];
        const float lf = logsigmoidf_(z[(size_t)s * INW + O_MG + (dir * 2 + 1) * 4 + h] + bg[(dir * 2 + 1) * 4 + h]);
        const float f = expf(lf), ig = expf(li);
        const float v = (tid < 256) ? z[(size_t)s * INW + O_MV + h * 256 + tid] : 1.f;
        __syncthreads();
        const float iv = ig * v;
        float num = 0.f;
#pragma unroll
        for (int j = 0; j < 128; ++j) { C[j] = f * C[j] + iv * ks[j]; num += qs[j] * C[j]; }
        if (tid == 256) den_s = num;
        __syncthreads();
        if (tid < 256) hs[((size_t)dir * SEQ + s) * 1024 + h * 256 + tid] = num / fmaxf(fabsf(den_s), 1.f);
    }
}

__global__ void __launch_bounds__(256) k_hm(const float* hs, const float* z, const float* g, float* hm) {
    const int s = blockIdx.x, h = threadIdx.x >> 6, l = threadIdx.x & 63;
    float v[4]; float ss = 0.f;
    for (int j = 0; j < 4; ++j) { const int c = h * 256 + l + 64 * j; v[j] = hs[(size_t)s * 1024 + c] + hs[((size_t)SEQ + s) * 1024 + c]; ss += v[j] * v[j]; }
    for (int o = 32; o > 0; o >>= 1) ss += __shfl_xor(ss, o);
    const float r = rsqrtf(ss * (1.f / 256.f) + EPS);
    for (int j = 0; j < 4; ++j) { const int c = h * 256 + l + 64 * j; hm[(size_t)s * 1024 + c] = v[j] * r * g[c] * sigmoidf_(z[(size_t)s * INW + O_MO + c]); }
}
__global__ void k_merge(const float* z, const float* ya, const float* ym, float* mg) {
    const size_t i = (size_t)blockIdx.x * blockDim.x + threadIdx.x;
    if (i >= (size_t)SEQ * 1024) return;
    const int s = (int)(i >> 10), c = (int)(i & 1023);
    mg[i] = sigmoidf_(z[(size_t)s * INW + O_BG + c]) * ya[i] + sigmoidf_(z[(size_t)s * INW + O_BG + 1024 + c]) * ym[i];
}
__global__ void k_plemul(const float* proj, const float* gpre, float* v) {
    const size_t i = (size_t)blockIdx.x * blockDim.x + threadIdx.x;
    if (i >= (size_t)SEQ * 1024) return;
    v[i] = proj[i] * sigmoidf_(gpre[i]);
}
}

extern "C" void kernel_launch(void* const* d_in, const int* in_sizes, int n_in, void* d_out, int out_size, void* d_ws, size_t ws_size, hipStream_t stream) {
    const float* x = (const float*)d_in[0]; const float* p = (const float*)d_in[1];
    const float* const* in = (const float* const*)d_in;
    float* out = (float*)d_out;
    float* ws = (float*)d_ws;
    size_t off = 0;
    auto take = [&](size_t n) { float* r = ws + off; off += (n + 63) & ~(size_t)63; return r; };
    float* cs = take((size_t)SEQ * 8); float* sn = take((size_t)SEQ * 8);
    float* xn = take((size_t)SEQ * D);
    float* big = take((size_t)SEQ * INW);
    float* hid = take((size_t)SEQ * FFN);
    float* y = take((size_t)SEQ * D);
    float* h1 = take((size_t)SEQ * D);
    float* att = take((size_t)SEQ * 512);
    float* cqk = take((size_t)SEQ * 1024);
    float* hs = take((size_t)2 * SEQ * 1024);
    float* hm = take((size_t)SEQ * 1024);
    float* ya = take((size_t)SEQ * 1024);
    float* ym = take((size_t)SEQ * 1024);
    float* mg = take((size_t)SEQ * 1024);
    float* h2 = take((size_t)SEQ * D);
    if (off * 4 > ws_size) { fprintf(stderr, "ws too small\n"); return; }
    auto gemm = [&](const float* A, int lda, const float* B, int ldb, float* C, int ldc, int M, int N, int K) {
        k_gemm<<<dim3((N + 63) / 64, M / 64), 256, 0, stream>>>(A, lda, B, ldb, C, ldc, M, N, K);
    };
    k_rope_tables<<<(SEQ * 8 + 255) / 256, 256, 0, stream>>>(cs, sn);
    const int EW = (SEQ * 1024 + 255) / 256;
    for (int b = 0; b < BATCH; ++b) {
        const float* xb = x + (size_t)b * SEQ * D; float* ob = out + (size_t)b * SEQ * D; const float* pb = p + (size_t)b * SEQ * PLE;
        k_rmsnorm<<<SEQ, 256, 0, stream>>>(xb, in[2], xn);
        gemm(xn, D, in[3], 2 * FFN, big, 2 * FFN, SEQ, 2 * FFN, D);
        k_swiglu<<<(SEQ * FFN + 255) / 256, 256, 0, stream>>>(big, hid, SEQ);
        gemm(hid, FFN, in[4], D, y, D, SEQ, D, FFN);
        k_resnorm<<<SEQ, 256, 0, stream>>>(xb, y, in[5], 0.5f, h1);
        k_rmsnorm<<<SEQ, 256, 0, stream>>>(h1, in[6], xn);
        gemm(xn, D, in[7], INW, big, INW, SEQ, INW, D);
        k_attn<<<SEQ * 8 / 64, 64, 0, stream>>>(big, cs, sn, in[11], att);
        k_conv<<<EW, 256, 0, stream>>>(big, in[9], in[10], cqk);
        k_mlstm<<<8, 320, 0, stream>>>(big, cqk, in[8], hs);
        k_hm<<<SEQ, 256, 0, stream>>>(hs, big, in[12], hm);
        gemm(att, 512, in[13], D, ya, D, SEQ, D, 512);
        gemm(hm, 1024, in[14], D, ym, D, SEQ, D, 1024);
        k_merge<<<EW, 256, 0, stream>>>(big, ya, ym, mg);
        gemm(mg, D, in[15], D, y, D, SEQ, D, D);
        k_resnorm<<<SEQ, 256, 0, stream>>>(h1, y, in[16], 1.0f, h2);
        k_rmsnorm<<<SEQ, 256, 0, stream>>>(h2, in[17], xn);
        gemm(xn, D, in[18], 2 * FFN, big, 2 * FFN, SEQ, 2 * FFN, D);
        k_swiglu<<<(SEQ * FFN + 255) / 256, 256, 0, stream>>>(big, hid, SEQ);
        gemm(hid, FFN, in[19], D, y, D, SEQ, D, FFN);
        k_resnorm<<<SEQ, 256, 0, stream>>>(h2, y, in[20], 0.5f, h1);
        k_rmsnorm<<<SEQ, 256, 0, stream>>>(h1, in[21], xn);
        gemm(xn, D, in[22], D, ya, D, SEQ, D, D);
        gemm(pb, PLE, in[23], D, ym, D, SEQ, D, PLE);
        k_plemul<<<EW, 256, 0, stream>>>(ym, ya, mg);
        k_resnorm<<<SEQ, 256, 0, stream>>>(h1, mg, in[24], 1.0f, ob);
    }
}
```

```cpp
#include <hip/hip_runtime.h>
#include <cstdio>
#include <cstdint>
namespace pg8 {
#define PG8_LAS __attribute__((address_space(3)))
typedef unsigned short bf16_t;
typedef short bf16x8 __attribute__((ext_vector_type(8)));
typedef float f32x4 __attribute__((ext_vector_type(4)));
typedef unsigned u32x4 __attribute__((ext_vector_type(4)));
constexpr int BM = 256, BK = 64, HALF = 128, HTB = HALF * BK * 2  , STAGE_BYTES = 8 * HTB, NXCD = 8, WGM = 8;

__host__ __device__ __forceinline__ int lds_byte(int r, int c) { const int st = (r >> 4) * 2 + (c >> 5), rr = r & 15, cc = c & 31, ob = rr * 64 + cc * 2; return st * 1024 + (ob ^ (((ob >> 9) & 1) << 5)); }
__host__ __device__ __forceinline__ void stage_rc(int b, int& R, int& C) { const int st = b / 1024, sb = b % 1024, swz = sb ^ (((sb >> 9) & 1) << 5); R = (st >> 1) * 16 + swz / 64; C = (st & 1) * 32 + (swz % 64) / 2; }
__host__ __device__ __forceinline__ int perm32(int rho) { const int n = rho >> 4, i = rho & 15; return 8 * (i >> 2) + 4 * n + (i & 3); }

struct Unit { int pm, pn; };
struct Gemm { const bf16_t* A; const bf16_t* Bt; int M, N, K; };

struct StaticOrder {
    int nM, nN, nwg, G, c;
    __host__ __device__ void init(int M, int N, int G_, int c_) { nM = M / BM; nN = N / BM; nwg = nM * nN; G = G_; c = c_; }
    __host__ __device__ bool next(int i, Unit& u) const {
        const long L = (long)i * G + c; if (L >= nwg) return false;
        int wgid = (int)L; { const int q = nwg / NXCD, r = nwg % NXCD, xcd = wgid % NXCD, off = wgid / NXCD; wgid = (xcd < r ? xcd * (q + 1) : r * (q + 1) + (xcd - r) * q) + off; }
        const int nig = WGM * nN, gid = wgid / nig, fm = gid * WGM, gsz = (nM - fm) < WGM ? (nM - fm) : WGM;
        u.pm = fm + ((wgid % nig) % gsz); u.pn = (wgid % nig) / gsz; return true;
    }
    __device__ __forceinline__ void a_ready(const Unit&) const {}
    __device__ __forceinline__ void done(const Unit&) const {}
};

typedef float f32x2 __attribute__((ext_vector_type(2)));
typedef __bf16 bf16x2_t __attribute__((ext_vector_type(2)));
__device__ __forceinline__ unsigned cvt_pk_bf16(float lo, float hi) { const f32x2 v = {lo, hi}; const bf16x2_t b = __builtin_convertvector(v, bf16x2_t); return __builtin_bit_cast(unsigned, b); }
typedef unsigned u32x2 __attribute__((ext_vector_type(2)));
constexpr float RMS_EPS = 1e-6f, LOG2E = 1.4426950408889634f, QSCALE = 0.125f * 1.4426950408889634f;
__device__ __forceinline__ float bf_lo(unsigned w) { return __uint_as_float(w << 16); }
__device__ __forceinline__ float bf_hi(unsigned w) { return __uint_as_float(w & 0xffff0000u); }
__device__ __forceinline__ float fsigmoid(float x) { return __builtin_amdgcn_rcpf(1.f + __builtin_amdgcn_exp2f(-LOG2E * x)); }
__device__ __forceinline__ void st_nt(u32x4* p, const u32x4 v) { __builtin_nontemporal_store(v, p); }
__device__ __forceinline__ float fsig2(float xs) { return __builtin_amdgcn_rcpf(1.f + __builtin_amdgcn_exp2f(xs)); }
__device__ __forceinline__ u32x4 pack8(const f32x4 a, const f32x4 b) { u32x4 w; w.x = cvt_pk_bf16(a[0], a[1]); w.y = cvt_pk_bf16(a[2], a[3]); w.z = cvt_pk_bf16(b[0], b[1]); w.w = cvt_pk_bf16(b[2], b[3]); return w; }
__device__ __forceinline__ u32x2 pack4(const f32x4 a) { u32x2 w; w.x = cvt_pk_bf16(a[0], a[1]); w.y = cvt_pk_bf16(a[2], a[3]); return w; }
__device__ __forceinline__ void unpack8(const u32x4 w, f32x4& a, f32x4& b) { a = (f32x4){bf_lo(w.x), bf_hi(w.x), bf_lo(w.y), bf_hi(w.y)}; b = (f32x4){bf_lo(w.z), bf_hi(w.z), bf_lo(w.w), bf_hi(w.w)}; }
__device__ __forceinline__ f32x4 unpack4(const u32x2 w) { return (f32x4){bf_lo(w.x), bf_hi(w.x), bf_lo(w.y), bf_hi(w.y)}; }

template <int mode> struct EpiSwigluT { static constexpr bool PERM = true, AFTER_DRAIN = false;
    bf16_t* H;
    __device__ __forceinline__ void operator()(const f32x4 (&acc)[2][2][4][2], const Unit& u, int wr, int wc, int fr, int fq) const {
        const int row0 = u.pm * BM + wr * 64 + fr, col0 = u.pn * HALF + wc * 32 + 8 * fq;
        if (mode == 2) { f32x4 t = {0.f, 0.f, 0.f, 0.f};
#pragma unroll
            for (int ai = 0; ai < 2; ++ai)
#pragma unroll
                for (int bj = 0; bj < 2; ++bj)
#pragma unroll
                    for (int m = 0; m < 4; ++m) t += acc[ai][bj][m][0] + acc[ai][bj][m][1];
            if (t[0] + t[1] + t[2] + t[3] == 1.2345678e-30f) *(float*)(H + (size_t)row0 * 2816 + col0) = t[0];
            return; }
#pragma unroll
        for (int ai = 0; ai < 2; ++ai)
#pragma unroll
            for (int m = 0; m < 4; ++m) { const int row = row0 + ai * HALF + m * 16;
                f32x4 h0, h1;
#pragma unroll
                for (int j = 0; j < 4; ++j) { const float g0 = acc[ai][0][m][0][j], g1 = acc[ai][0][m][1][j]; h0[j] = g0 * fsig2(g0) * acc[ai][1][m][0][j]; h1[j] = g1 * fsig2(g1) * acc[ai][1][m][1][j]; }
                if (mode == 0) st_nt((u32x4*)(H + (size_t)row * 2816 + col0), pack8(h0, h1));
                else if (mode == 1) { const u32x4 w = pack8(h0, h1); if ((w.x ^ w.y ^ w.z ^ w.w) == 0x12345679u) *(u32x4*)(H + (size_t)row * 2816 + col0) = w; } }
    }
};
typedef EpiSwigluT<0> EpiSwiglu;
struct EpiRoute { static constexpr bool PERM = true, AFTER_DRAIN = false;
    bf16_t *AQ, *AKV, *MQK, *MV, *MO; float* GATES; const float* cs; const float* sn; const float* bgate;
    __device__ __forceinline__ void operator()(const f32x4 (&acc)[2][2][4][2], const Unit& u, int wr, int wc, int fr, int fq) const {
        const int pn = u.pn, row0 = u.pm * BM + wr * 64 + fr, cw = wc * 32 + 8 * fq;
        if (pn <= 2) {
            const bool rope_lane = (wc & 1) == 0 && fq < 2;
#pragma unroll
            for (int ai = 0; ai < 2; ++ai) {
                f32x4 cc[4], ss[4];
#pragma unroll
                for (int m = 0; m < 4; ++m) { const int s = (row0 + ai * HALF + m * 16) & 4095; cc[m] = (f32x4){1.f, 1.f, 1.f, 1.f}; ss[m] = (f32x4){0.f, 0.f, 0.f, 0.f};
                    if (rope_lane) { cc[m] = *(const f32x4*)(cs + s * 8 + 4 * fq); ss[m] = *(const f32x4*)(sn + s * 8 + 4 * fq); } }
                asm volatile("" ::: "memory");
#pragma unroll
                for (int m = 0; m < 4; ++m) { const int row = row0 + ai * HALF + m * 16; const float r = (pn < 2 ? QSCALE : 1.0f);
#pragma unroll
                    for (int bj = 0; bj < 2; ++bj) { const f32x4 v0 = acc[ai][bj][m][0] * r, v1 = acc[ai][bj][m][1] * r; const int tc = bj * HALF + cw;
                        bf16_t* dst = (pn < 2) ? AQ + (size_t)row * 512 + pn * 256 + tc : AKV + (size_t)row * 256 + tc;
                        if (rope_lane && !(pn == 2 && bj == 1)) {
                            const f32x4 r1 = v0 * cc[m] - v1 * ss[m], r2 = v1 * cc[m] + v0 * ss[m];
                            dst -= 8 * fq;
                            *(u32x2*)(dst + 4 * fq) = pack4(r1); *(u32x2*)(dst + 8 + 4 * fq) = pack4(r2);
                        } else *(u32x4*)dst = pack8(v0, v1); } }
                asm volatile("" ::: "memory"); }
        } else if (pn <= 14) {
            bf16_t* base = (pn <= 6) ? MQK + (pn - 3) * 256 : (pn <= 10) ? MV + (pn - 7) * 256 : MO + (pn - 11) * 256; const bool sg = pn > 10;
#pragma unroll
            for (int ai = 0; ai < 2; ++ai)
#pragma unroll
                for (int m = 0; m < 4; ++m) { const int row = row0 + ai * HALF + m * 16;
#pragma unroll
                    for (int bj = 0; bj < 2; ++bj) { f32x4 v0 = acc[ai][bj][m][0], v1 = acc[ai][bj][m][1];
                        if (sg) {
#pragma unroll
                            for (int j = 0; j < 4; ++j) { v0[j] = fsig2(v0[j]); v1[j] = fsig2(v1[j]); } }
                        st_nt((u32x4*)(base + (size_t)row * 1024 + bj * HALF + cw), pack8(v0, v1)); } }
        } else if (wc == 0 && fq < 2) {
            const f32x4 b0 = *(const f32x4*)(bgate + 8 * fq), b1 = *(const f32x4*)(bgate + 8 * fq + 4);
#pragma unroll
            for (int ai = 0; ai < 2; ++ai)
#pragma unroll
                for (int m = 0; m < 4; ++m) { const int row = row0 + ai * HALF + m * 16;
                    const f32x4 li = acc[ai][0][m][0] + b0; f32x4 lf = acc[ai][0][m][1] + b1;
#pragma unroll
                    for (int j = 0; j < 4; ++j) lf[j] = fminf(lf[j], 0.f) - log1pf(expf(-fabsf(lf[j])));
                    *(f32x4*)(GATES + (size_t)row * 16 + 8 * fq) = li; *(f32x4*)(GATES + (size_t)row * 16 + 8 * fq + 4) = lf; }
        }
    }
};
struct EpiSig { static constexpr bool PERM = true, AFTER_DRAIN = false;
    bf16_t *BGA, *BGM;
    __device__ __forceinline__ void operator()(const f32x4 (&acc)[2][2][4][2], const Unit& u, int wr, int wc, int fr, int fq) const {
        const int row0 = u.pm * BM + wr * 64 + fr, cw = wc * 32 + 8 * fq; bf16_t* base = (u.pn < 4) ? BGA + u.pn * 256 : BGM + (u.pn - 4) * 256;
#pragma unroll
        for (int ai = 0; ai < 2; ++ai)
#pragma unroll
            for (int m = 0; m < 4; ++m) { const int row = row0 + ai * HALF + m * 16;
#pragma unroll
                for (int bj = 0; bj < 2; ++bj) { f32x4 v0 = acc[ai][bj][m][0], v1 = acc[ai][bj][m][1];
#pragma unroll
                    for (int j = 0; j < 4; ++j) { v0[j] = fsig2(v0[j]); v1[j] = fsig2(v1[j]); }
                    st_nt((u32x4*)(base + (size_t)row * 1024 + bj * HALF + cw), pack8(v0, v1)); } }
    }
};
template <bool ADD> struct EpiMul { static constexpr bool PERM = true, AFTER_DRAIN = false;
    bf16_t* O; const bf16_t* G; const bf16_t* T;
    __device__ __forceinline__ void operator()(const f32x4 (&acc)[2][2][4][2], const Unit& u, int wr, int wc, int fr, int fq) const {
        const int row0 = u.pm * BM + wr * 64 + fr, col0 = u.pn * BM + wc * 32 + 8 * fq;
#pragma unroll
        for (int ai = 0; ai < 2; ++ai) {
            u32x4 gq[4][2], tq[4][2];
#pragma unroll
            for (int m = 0; m < 4; ++m)
#pragma unroll
                for (int bj = 0; bj < 2; ++bj) { const size_t ro = (size_t)(row0 + ai * HALF + m * 16) * 1024 + col0 + bj * HALF; gq[m][bj] = *(const u32x4*)(G + ro); if (ADD) tq[m][bj] = *(const u32x4*)(T + ro); }
            asm volatile("" ::: "memory");
#pragma unroll
            for (int m = 0; m < 4; ++m)
#pragma unroll
                for (int bj = 0; bj < 2; ++bj) { f32x4 g0, g1; unpack8(gq[m][bj], g0, g1); f32x4 v0 = acc[ai][bj][m][0] * g0, v1 = acc[ai][bj][m][1] * g1;
                    if (ADD) { f32x4 t0, t1; unpack8(tq[m][bj], t0, t1); v0 = v0 + t0; v1 = v1 + t1; }
                    gq[m][bj] = pack8(v0, v1); }
#pragma unroll
            for (int m = 0; m < 4; ++m)
#pragma unroll
                for (int bj = 0; bj < 2; ++bj) st_nt((u32x4*)(O + (size_t)(row0 + ai * HALF + m * 16) * 1024 + col0 + bj * HALF), gq[m][bj]);
            asm volatile("" ::: "memory"); }
    }
};
struct EpiPlainNP { static constexpr bool PERM = true, AFTER_DRAIN = false;
    bf16_t* O;
    __device__ __forceinline__ void operator()(const f32x4 (&acc)[2][2][4][2], const Unit& u, int wr, int wc, int fr, int fq) const {
        const int row0 = u.pm * BM + wr * 64 + fr, col0 = u.pn * BM + wc * 32 + 8 * fq;
#pragma unroll
        for (int ai = 0; ai < 2; ++ai)
#pragma unroll
            for (int m = 0; m < 4; ++m) { const size_t ro = (size_t)(row0 + ai * HALF + m * 16) * 1024 + col0;
#pragma unroll
                for (int bj = 0; bj < 2; ++bj) st_nt((u32x4*)(O + ro + bj * HALF), pack8(acc[ai][bj][m][0], acc[ai][bj][m][1])); }
    }
};
struct PanelSsq {
    unsigned* xbuf;
    unsigned* cnt;
    unsigned* tmo; unsigned code;
    __device__ __forceinline__ static void partials(const f32x4 (&v)[2][2][4][2], int wr, int wc, int fr, int fq, PG8_LAS float* P) {
#pragma unroll
        for (int ai = 0; ai < 2; ++ai)
#pragma unroll
            for (int m = 0; m < 4; ++m) { float s = 0.f;
#pragma unroll
                for (int bj = 0; bj < 2; ++bj)
#pragma unroll
                    for (int n = 0; n < 2; ++n) { const f32x4 x = v[ai][bj][m][n]; s += (x[0] * x[0] + x[1] * x[1]) + (x[2] * x[2] + x[3] * x[3]); }
                s += __shfl_xor(s, 16); s += __shfl_xor(s, 32);
                if (fq == 0) P[(ai * HALF + wr * 64 + m * 16 + fr) * 4 + wc] = s; }
    }
    __device__ __forceinline__ bool run(const f32x4 (&v)[2][2][4][2], const Unit& u, int wr, int wc, int fr, int fq, PG8_LAS unsigned char* lds, int wid, int lane) const {
        PG8_LAS float* P = (PG8_LAS float*)lds;
        PG8_LAS float* S = (PG8_LAS float*)(lds + 8192);
        PG8_LAS unsigned* flag = (PG8_LAS unsigned*)(lds + 8192 + 2048);
        partials(v, wr, wc, fr, fq, P);
        if (wid == 0 && lane == 0) flag[0] = 0u;
        asm volatile("s_waitcnt lgkmcnt(0)" ::: "memory"); __builtin_amdgcn_s_barrier(); asm volatile("" ::: "memory");
        const int row = wid * 32 + (lane & 31);
        if (lane < 32) { const float t = (P[row * 4 + 0] + P[row * 4 + 1]) + (P[row * 4 + 2] + P[row * 4 + 3]);
            unsigned* slot = xbuf + (size_t)(u.pm * BM + row) * 4;
            __hip_atomic_store(slot + u.pn, __float_as_uint(t) | 1u, __ATOMIC_RELAXED, __HIP_MEMORY_SCOPE_AGENT);
            unsigned a0, a1, a2, a3; bool okk; int it = 0;
            do {
                a0 = __hip_atomic_load(slot + 0, __ATOMIC_RELAXED, __HIP_MEMORY_SCOPE_AGENT); a1 = __hip_atomic_load(slot + 1, __ATOMIC_RELAXED, __HIP_MEMORY_SCOPE_AGENT);
                a2 = __hip_atomic_load(slot + 2, __ATOMIC_RELAXED, __HIP_MEMORY_SCOPE_AGENT); a3 = __hip_atomic_load(slot + 3, __ATOMIC_RELAXED, __HIP_MEMORY_SCOPE_AGENT);
                okk = (a0 != 0u) & (a1 != 0u) & (a2 != 0u) & (a3 != 0u);
                if (__all(okk)) break;
                __builtin_amdgcn_s_sleep(1);
            } while (++it < 40000);
            const bool dead = !okk;
            if (dead) { __hip_atomic_store(tmo + 1, code | (unsigned)(u.pm & 0xff), __ATOMIC_RELAXED, __HIP_MEMORY_SCOPE_AGENT); __hip_atomic_store(tmo, 1u, __ATOMIC_RELAXED, __HIP_MEMORY_SCOPE_AGENT); flag[0] = 1u; }
            const float tt = (__uint_as_float(a0) + __uint_as_float(a1)) + (__uint_as_float(a2) + __uint_as_float(a3));
            S[row] = rsqrtf(tt * (1.f / 1024.f) + RMS_EPS); }
        asm volatile("s_waitcnt vmcnt(0) lgkmcnt(0)" ::: "memory"); __builtin_amdgcn_s_barrier(); asm volatile("" ::: "memory");
        const bool bad = flag[0] != 0u;
        return bad;
    }
};
struct EpiRmsRes { static constexpr bool PERM = true, AFTER_DRAIN = true;
    bf16_t* xn; const float* inv_prev; float* inv_new; const float* gpost; float scale; PanelSsq st, st2; unsigned poison;
    __device__ __forceinline__ void fused(f32x4 (&acc)[2][2][4][2], const Unit& u, int wr, int wc, int fr, int fq, PG8_LAS unsigned char* lds, int wid, int lane) const {
        const PG8_LAS float* S = (const PG8_LAS float*)(lds + 8192);
        const int col0 = u.pn * BM + wc * 32 + 8 * fq, row0 = u.pm * BM + wr * 64 + fr;
        const float sc_ = scale;
        u32x4 pre[4][2]; float iv[2][4];
#pragma unroll
        for (int m = 0; m < 4; ++m)
#pragma unroll
            for (int bj = 0; bj < 2; ++bj) pre[m][bj] = *(const u32x4*)(xn + (size_t)(row0 + m * 16) * 1024 + col0 + bj * HALF);
        const bool bad = st.run(acc, u, wr, wc, fr, fq, lds, wid, lane) || poison != 0u;
        int row1 = row0, col1 = col0; asm volatile("" : "+v"(row1), "+v"(col1));
#pragma unroll
        for (int ai = 0; ai < 2; ++ai)
#pragma unroll
            for (int m = 0; m < 4; ++m) iv[ai][m] = inv_prev[row1 + ai * HALF + m * 16];
        f32x4 gp[2][2];
#pragma unroll
        for (int bj = 0; bj < 2; ++bj)
#pragma unroll
            for (int n = 0; n < 2; ++n) { const f32x4 g4 = *(const f32x4*)(gpost + col1 + bj * HALF + 4 * n); gp[bj][n] = (f32x4){g4[0] * sc_, g4[1] * sc_, g4[2] * sc_, g4[3] * sc_}; }
#pragma unroll
        for (int ai = 0; ai < 2; ++ai) {
#pragma unroll
            for (int m = 0; m < 4; ++m) { const float sr = S[ai * HALF + wr * 64 + m * 16 + fr], ivr = iv[ai][m];
#pragma unroll
                for (int bj = 0; bj < 2; ++bj) { f32x4 b0, b1; unpack8(pre[m][bj], b0, b1);
                    acc[ai][bj][m][0] = b0 * ivr + acc[ai][bj][m][0] * sr * gp[bj][0]; acc[ai][bj][m][1] = b1 * ivr + acc[ai][bj][m][1] * sr * gp[bj][1]; } }
            if (ai == 0) {
#pragma unroll
                for (int m = 0; m < 4; ++m)
#pragma unroll
                    for (int bj = 0; bj < 2; ++bj) pre[m][bj] = *(const u32x4*)(xn + (size_t)(row1 + HALF + m * 16) * 1024 + col1 + bj * HALF);
            }
        }
        const bool bad2 = st2.run(acc, u, wr, wc, fr, fq, lds, wid, lane) || bad;
#pragma unroll
        for (int ai = 0; ai < 2; ++ai)
#pragma unroll
            for (int m = 0; m < 4; ++m) { const float sr = S[ai * HALF + wr * 64 + m * 16 + fr]; const size_t off = (size_t)(row1 + ai * HALF + m * 16) * 1024 + col1;
#pragma unroll
                for (int bj = 0; bj < 2; ++bj) { u32x4 w = pack8(acc[ai][bj][m][0] * sr, acc[ai][bj][m][1] * sr); if (bad2) w = (u32x4){0x7fc07fc0u, 0x7fc07fc0u, 0x7fc07fc0u, 0x7fc07fc0u}; *(u32x4*)(xn + off + bj * HALF) = w; } }
        if (u.pn == 0 && lane < 32) { const int row = wid * 32 + lane; inv_new[u.pm * BM + row] = 1.0f / S[row]; }
    }
};
struct EpiPle { static constexpr bool PERM = true, AFTER_DRAIN = true;
    const bf16_t* xn; const float* inv_prev; float* out; const bf16_t* PR; const float* gpost; PanelSsq st; unsigned poison;
    __device__ __forceinline__ void fused(f32x4 (&acc)[2][2][4][2], const Unit& u, int wr, int wc, int fr, int fq, PG8_LAS unsigned char* lds, int wid, int lane) const {
        const PG8_LAS float* S = (const PG8_LAS float*)(lds + 8192);
        const int col0 = u.pn * BM + wc * 32 + 8 * fq, row0 = u.pm * BM + wr * 64 + fr;
#pragma unroll
        for (int ai = 0; ai < 2; ++ai) {
            u32x4 prq[4][2];
#pragma unroll
            for (int m = 0; m < 4; ++m)
#pragma unroll
                for (int bj = 0; bj < 2; ++bj) prq[m][bj] = *(const u32x4*)(PR + (size_t)(row0 + ai * HALF + m * 16) * 1024 + col0 + bj * HALF);
            asm volatile("" ::: "memory");
#pragma unroll
            for (int m = 0; m < 4; ++m)
#pragma unroll
                for (int bj = 0; bj < 2; ++bj) { f32x4 p0, p1; unpack8(prq[m][bj], p0, p1); f32x4 a0 = acc[ai][bj][m][0], a1 = acc[ai][bj][m][1];
#pragma unroll
                    for (int j = 0; j < 4; ++j) { a0[j] = fsig2(a0[j]); a1[j] = fsig2(a1[j]); }
                    acc[ai][bj][m][0] = p0 * a0; acc[ai][bj][m][1] = p1 * a1; }
            asm volatile("" ::: "memory"); }
        const bool bad = st.run(acc, u, wr, wc, fr, fq, lds, wid, lane) || poison != 0u;
        asm volatile("" ::: "memory");
        const float qnan = __builtin_nanf("");
        f32x4 gp[2][2];
#pragma unroll
        for (int bj = 0; bj < 2; ++bj)
#pragma unroll
            for (int n = 0; n < 2; ++n) gp[bj][n] = *(const f32x4*)(gpost + col0 + bj * HALF + 4 * n);
#pragma unroll
        for (int ai = 0; ai < 2; ++ai)
#pragma unroll
            for (int mp = 0; mp < 2; ++mp) {
                u32x4 pre[2][2]; float iv[2];
#pragma unroll
                for (int mm = 0; mm < 2; ++mm) { const int m = 2 * mp + mm; iv[mm] = inv_prev[row0 + ai * HALF + m * 16];
#pragma unroll
                    for (int bj = 0; bj < 2; ++bj) pre[mm][bj] = *(const u32x4*)(xn + (size_t)(row0 + ai * HALF + m * 16) * 1024 + col0 + bj * HALF); }
                asm volatile("" ::: "memory");
#pragma unroll
                for (int mm = 0; mm < 2; ++mm) { const int m = 2 * mp + mm; const float sr = S[ai * HALF + wr * 64 + m * 16 + fr]; const size_t off = (size_t)(row0 + ai * HALF + m * 16) * 1024 + col0;
#pragma unroll
                    for (int bj = 0; bj < 2; ++bj) { f32x4 b0, b1; unpack8(pre[mm][bj], b0, b1);
                        f32x4 o0 = b0 * iv[mm] + acc[ai][bj][m][0] * sr * gp[bj][0], o1 = b1 * iv[mm] + acc[ai][bj][m][1] * sr * gp[bj][1];
                        if (bad) { o0 = (f32x4){qnan, qnan, qnan, qnan}; o1 = o0; }
                        *(f32x4*)(out + off + bj * HALF) = o0; *(f32x4*)(out + off + bj * HALF + 4) = o1; } }
                asm volatile("" ::: "memory"); }
    }
};
struct QueueOrder { StaticOrder so; unsigned* ctr; int limit; PG8_LAS int* slot; int wave, xlab;
    __device__ __forceinline__ bool next(int i, Unit& u) const {
        if (wave == 0) { int v = 0; int l_; asm volatile("v_mbcnt_lo_u32_b32 %0, -1, 0\n\tv_mbcnt_hi_u32_b32 %0, -1, %0" : "=v"(l_));
            if (l_ == 0) v = (int)__hip_atomic_fetch_add(ctr, 1u, __ATOMIC_RELAXED, __HIP_MEMORY_SCOPE_AGENT);
            v = __builtin_amdgcn_readfirstlane(v); if (l_ == 0) slot[i & 1] = v; }
        asm volatile("s_waitcnt vmcnt(0) lgkmcnt(0)" ::: "memory"); __builtin_amdgcn_s_barrier(); asm volatile("" ::: "memory");
        const int tk = __builtin_amdgcn_readfirstlane(slot[i & 1]);
        const int L = NXCD * tk + xlab;
        if (L >= limit) return false; StaticOrder t = so; t.G = 1; t.c = 0; return t.next(L, u); }
    __device__ __forceinline__ void a_ready(const Unit&) const {}
    __device__ __forceinline__ void done(const Unit&) const {}
};
struct RoundOrder { StaticOrder so; int round;
    __device__ __forceinline__ bool next(int i, Unit& u) const { return i == 0 && so.next(round, u); }
    __device__ __forceinline__ void a_ready(const Unit&) const {}
    __device__ __forceinline__ void done(const Unit&) const {}
};
__device__ __forceinline__ void zero4(f32x4& v) {
    typedef unsigned long long u64x2_ __attribute__((ext_vector_type(2)));
    unsigned long long lo, hi;
    asm volatile("v_mov_b64 %0, 0" : "=v"(lo)); asm volatile("v_mov_b64 %0, 0" : "=v"(hi));
    const u64x2_ z = {lo, hi}; v = __builtin_bit_cast(f32x4, z);
}
template <int KK, class Epi, class Sched, bool ALIGN_EPI = false, bool SP2 = false, bool ABLK = false>
__device__ __forceinline__ void gemm_phase(PG8_LAS unsigned char* lds, const Gemm g, const Sched& S, const Epi& E, const int wave_s) {
    int tid_; asm volatile("v_mbcnt_lo_u32_b32 %0, -1, 0\n\tv_mbcnt_hi_u32_b32 %0, -1, %0" : "=v"(tid_)); tid_ += wave_s * 64;
    const int tid = tid_, wid = wave_s, lane = tid & 63, wr = wid >> 2, wc = wid & 3, fr = lane & 15, fq = lane >> 4;
    constexpr int K = KK, nt = K / BK;
    unsigned voffA[2], voffB[2];
#pragma unroll
    for (int i = 0; i < 2; ++i) { int R, C; stage_rc(tid * 16 + i * 8192, R, C); const int Rb = Epi::PERM ? ((R & ~31) + perm32(R & 31)) : R;
        voffA[i] = ABLK ? (unsigned)(((R >> 1) * (K / 32) + (C >> 5)) * 128 + (R & 1) * 64 + (C & 31) * 2) : (unsigned)(R * K + C) * 2u; voffB[i] = (unsigned)(Rb * K + C) * 2u; }
    const size_t kstep = (size_t)(BK * 2);
    const size_t kstepA = ABLK ? (size_t)256 : kstep;
    const size_t hstep = (size_t)HALF * K * 2;
    const size_t tstep = 2 * hstep;
    const unsigned ldsw = (unsigned)wid * 1024u;
    const int aoff = lds_byte(wr * 64 + fr, fq * 8), boff = lds_byte(wc * 32 + fr, fq * 8);
#define PG8_SA(b, h) (((b) * 2 + (h)) * HTB)
#define PG8_SB(b, h) ((4 + (b) * 2 + (h)) * HTB)
#define PG8_STAGE(bufoff, gbase, voff) do { _Pragma("unroll") for (int _i = 0; _i < 2; ++_i) \
        __builtin_amdgcn_global_load_lds((const unsigned*)((const char*)(gbase) + (voff)[_i]), (PG8_LAS unsigned*)(lds + (bufoff) + ldsw + _i * 8192), 16, 0, 0); } while (0)
#define PG8_LDA(dst, b, h) do { _Pragma("unroll") for (int m = 0; m < 4; ++m) _Pragma("unroll") for (int k = 0; k < 2; ++k) dst[m][k] = *(const PG8_LAS bf16x8*)(lds + PG8_SA(b, h) + aoff + m * 2048 + k * 1024); } while (0)
#define PG8_LDB(dst, b, h) do { _Pragma("unroll") for (int n = 0; n < 2; ++n) _Pragma("unroll") for (int k = 0; k < 2; ++k) dst[n][k] = *(const PG8_LAS bf16x8*)(lds + PG8_SB(b, h) + boff + n * 2048 + k * 1024); } while (0)
#define PG8_MMA(ai, bj, At, Bt) do { __builtin_amdgcn_s_setprio(1); _Pragma("unroll") for (int m = 0; m < 4; ++m) _Pragma("unroll") for (int n = 0; n < 2; ++n) _Pragma("unroll") for (int k = 0; k < 2; ++k) \
        acc[ai][bj][m][n] = __builtin_amdgcn_mfma_f32_16x16x32_bf16(Bt[n][k], At[m][k], acc[ai][bj][m][n], 0, 0, 0); __builtin_amdgcn_s_setprio(0); } while (0)
#define PG8_WAIT_V(n) asm volatile("s_waitcnt vmcnt(" #n ")" ::: "memory")
#define PG8_WAIT_L(n) asm volatile("s_waitcnt lgkmcnt(" #n ")" ::: "memory")
#define PG8_BAR __builtin_amdgcn_s_barrier()
#define PG8_SCHED __builtin_amdgcn_sched_barrier(0)
    Unit cur, nxt; int ui = 0;
    if (!S.next(0, cur)) return;
    f32x4 acc[2][2][4][2];
#pragma unroll
    for (int a = 0; a < 2; ++a)
#pragma unroll
        for (int b = 0; b < 2; ++b)
#pragma unroll
            for (int m = 0; m < 4; ++m)
#pragma unroll
                for (int n = 0; n < 2; ++n) acc[a][b][m][n] = (f32x4){0.f, 0.f, 0.f, 0.f};
    bf16x8 At[4][2], B0[2][2], B1[2][2];
    const char* cA = (const char*)g.A + (size_t)cur.pm * tstep; const char* cB = (const char*)g.Bt + (size_t)cur.pn * tstep;
    S.a_ready(cur);
    if constexpr (SP2) {
        PG8_STAGE(PG8_SB(0, 0), cB, voffB); PG8_STAGE(PG8_SB(0, 1), cB + hstep, voffB); PG8_STAGE(PG8_SA(0, 0), cA, voffA); PG8_STAGE(PG8_SA(0, 1), cA + hstep, voffA);
        if (wr == 1) PG8_BAR;
        PG8_WAIT_V(2); PG8_BAR;
        PG8_STAGE(PG8_SB(1, 0), cB + kstep, voffB); PG8_STAGE(PG8_SA(1, 0), cA + kstepA, voffA); PG8_STAGE(PG8_SB(1, 1), cB + hstep + kstep, voffB);
        PG8_WAIT_V(6); PG8_BAR;
    } else {
        PG8_STAGE(PG8_SB(0, 0), cB, voffB); PG8_STAGE(PG8_SA(0, 0), cA, voffA); PG8_STAGE(PG8_SB(0, 1), cB + hstep, voffB); PG8_STAGE(PG8_SA(0, 1), cA + hstep, voffA);
        if (wr == 1) PG8_BAR;
        PG8_WAIT_V(4); PG8_BAR;
        PG8_STAGE(PG8_SB(1, 0), cB + kstep, voffB); PG8_STAGE(PG8_SA(1, 0), cA + kstepA, voffA); PG8_STAGE(PG8_SB(1, 1), cB + hstep + kstep, voffB);
        PG8_WAIT_V(6); PG8_BAR;
    }
    for (;;) {
        const bool has_next = S.next(ui + 1, nxt);
        const char* nA = has_next ? (const char*)g.A + (size_t)nxt.pm * tstep : cA; const char* nB = has_next ? (const char*)g.Bt + (size_t)nxt.pn * tstep : cB;
#pragma nounroll
        for (int t = 0; t < nt; t += 2) {
            const bool last = (t == nt - 2);
            const char* a1 = cA + (size_t)(t + 1) * kstepA;
            const char* a2 = last ? nA : cA + (size_t)(t + 2) * kstepA; const char* b2 = last ? nB : cB + (size_t)(t + 2) * kstep;
            const char* a3 = a2 + kstepA; const char* b3 = b2 + kstep;
            if (last && has_next) S.a_ready(nxt);
            if constexpr (SP2) {
            PG8_LDB(B0, 0, 0); PG8_LDB(B1, 0, 1); PG8_SCHED; PG8_LDA(At, 0, 0); PG8_STAGE(PG8_SA(1, 1), a1 + hstep, voffA);
            PG8_WAIT_V(8); PG8_WAIT_L(0); PG8_BAR; PG8_MMA(0, 0, At, B0); PG8_MMA(0, 1, At, B1); PG8_BAR; PG8_SCHED;
            PG8_LDA(At, 0, 1); PG8_STAGE(PG8_SB(0, 0), b2, voffB); PG8_STAGE(PG8_SB(0, 1), b2 + hstep, voffB); PG8_STAGE(PG8_SA(0, 0), a2, voffA);
            PG8_WAIT_V(8); PG8_WAIT_L(0); PG8_BAR; PG8_MMA(1, 0, At, B0); PG8_MMA(1, 1, At, B1); PG8_BAR; PG8_SCHED;
            PG8_LDB(B0, 1, 0); PG8_LDB(B1, 1, 1); PG8_SCHED; PG8_LDA(At, 1, 0); PG8_STAGE(PG8_SA(0, 1), a2 + hstep, voffA);
            PG8_WAIT_V(8); PG8_WAIT_L(0); PG8_BAR; PG8_MMA(0, 0, At, B0); PG8_MMA(0, 1, At, B1); PG8_BAR; PG8_SCHED;
            PG8_LDA(At, 1, 1); PG8_STAGE(PG8_SB(1, 0), b3, voffB); PG8_STAGE(PG8_SB(1, 1), b3 + hstep, voffB); PG8_STAGE(PG8_SA(1, 0), a3, voffA);
            PG8_WAIT_V(8); PG8_WAIT_L(0); PG8_BAR; PG8_MMA(1, 0, At, B0); PG8_MMA(1, 1, At, B1); PG8_BAR; PG8_SCHED;
            } else {
            PG8_LDB(B0, 0, 0); PG8_SCHED; PG8_LDA(At, 0, 0); PG8_STAGE(PG8_SA(1, 1), a1 + hstep, voffA);
            PG8_WAIT_L(8); PG8_BAR; PG8_WAIT_L(0); PG8_MMA(0, 0, At, B0); PG8_BAR; PG8_SCHED;
            PG8_LDB(B1, 0, 1); PG8_STAGE(PG8_SB(0, 0), b2, voffB);
            PG8_BAR; PG8_WAIT_L(0); PG8_MMA(0, 1, At, B1); PG8_BAR;
            PG8_LDA(At, 0, 1); PG8_STAGE(PG8_SA(0, 0), a2, voffA);
            PG8_BAR; PG8_WAIT_L(0); PG8_MMA(1, 0, At, B0); PG8_BAR; PG8_SCHED;
            PG8_STAGE(PG8_SB(0, 1), b2 + hstep, voffB);
            PG8_WAIT_V(6); PG8_BAR; PG8_MMA(1, 1, At, B1); PG8_BAR;
            PG8_LDB(B0, 1, 0); PG8_SCHED; PG8_LDA(At, 1, 0); PG8_STAGE(PG8_SA(0, 1), a2 + hstep, voffA);
            PG8_WAIT_L(8); PG8_BAR; PG8_WAIT_L(0); PG8_MMA(0, 0, At, B0); PG8_BAR; PG8_SCHED;
            PG8_LDB(B1, 1, 1); PG8_STAGE(PG8_SB(1, 0), b3, voffB);
            PG8_BAR; PG8_WAIT_L(0); PG8_MMA(0, 1, At, B1); PG8_BAR;
            PG8_LDA(At, 1, 1); PG8_STAGE(PG8_SA(1, 0), a3, voffA);
            PG8_BAR; PG8_WAIT_L(0); PG8_MMA(1, 0, At, B0); PG8_BAR; PG8_SCHED;
            PG8_STAGE(PG8_SB(1, 1), b3 + hstep, voffB);
            PG8_WAIT_V(6); PG8_BAR; PG8_MMA(1, 1, At, B1); PG8_BAR;
            }
        }
        if constexpr (ALIGN_EPI) { if (wr == 0) PG8_BAR; }
        if constexpr (!Epi::AFTER_DRAIN) { int fr_ = fr, fq_ = fq; asm volatile("" : "+v"(fr_), "+v"(fq_));
            E(acc, cur, wr, wc, fr_, fq_); S.done(cur); }
        if (!has_next) break;
#pragma unroll
        for (int a = 0; a < 2; ++a)
#pragma unroll
            for (int b = 0; b < 2; ++b)
#pragma unroll
                for (int m = 0; m < 4; ++m)
#pragma unroll
                    for (int n = 0; n < 2; ++n) zero4(acc[a][b][m][n]);
        cur = nxt; cA = nA; cB = nB; ++ui;
        if constexpr (ALIGN_EPI) { if (wr == 1) PG8_BAR; }
    }
    PG8_WAIT_V(0);
    if constexpr (!ALIGN_EPI) { if (wr == 0) PG8_BAR; }
    PG8_BAR;
    if constexpr (Epi::AFTER_DRAIN) { int fr_ = fr, fq_ = fq, lane_ = lane; asm volatile("" : "+v"(fr_), "+v"(fq_), "+v"(lane_)); E.fused(acc, cur, wr, wc, fr_, fq_, lds, wid, lane_); S.done(cur); }
#undef PG8_SA
#undef PG8_SB
#undef PG8_STAGE
#undef PG8_LDA
#undef PG8_LDB
#undef PG8_MMA
#undef PG8_WAIT_V
#undef PG8_WAIT_L
#undef PG8_BAR
#undef PG8_SCHED
}
}
constexpr int NWAVES = 8;
constexpr int BATCH = 8, SEQ = 4096, DM = 1024, PLE_DIM = 256, FFN = 2816, M = BATCH * SEQ;
constexpr int INW = 5904;
constexpr size_t MiB = 1u << 20;
constexpr size_t WS_CTL = 0, CTL_ZERO_BYTES = 1 * MiB;
constexpr size_t WS_W1A = 2 * MiB, WS_W2A = WS_W1A + 11 * MiB, WS_WINA = WS_W2A + 11 * MiB / 2, WS_WINB = WS_WINA + 8 * MiB, WS_WBA = WS_WINB + 4 * MiB, WS_WBM = WS_WBA + 1 * MiB,
                 WS_WOUT = WS_WBM + 2 * MiB, WS_W1B = WS_WOUT + 2 * MiB, WS_W2B = WS_W1B + 11 * MiB, WS_WPG = WS_W2B + 11 * MiB / 2, WS_WPP = WS_WPG + 2 * MiB, WS_WEND = WS_WPP + MiB / 2;
static_assert(WS_WEND <= 55 * MiB, "weights");
constexpr size_t WS_ROPE = 55 * MiB;
constexpr size_t WS_SSQ = 56 * MiB;
constexpr size_t WS_GATES = 58 * MiB;
constexpr size_t WS_XBUF = 60 * MiB;
constexpr size_t WS_XN = 64 * MiB;
constexpr size_t WS_AQ = 128 * MiB, WS_AKV = 160 * MiB, WS_MQK = 176 * MiB, WS_MV = 240 * MiB, WS_MO = 304 * MiB, WS_CQK = 368 * MiB, WS_HSF = 176 * MiB, WS_HSB = 432 * MiB, WS_HM = 304 * MiB;
constexpr size_t WS_BGA = 240 * MiB, WS_BGM = 176 * MiB, WS_T1 = 432 * MiB, WS_MG = 368 * MiB, WS_H = 128 * MiB, WS_PR = 304 * MiB, WS_PB = 496 * MiB, WS_END = 512 * MiB;
constexpr int CW_TMO = 0, CW_CODE = 1;
constexpr int CW_HMG = 2048;
constexpr int CW_G3BQ = 1024;
constexpr int CW_BAR = 4096;
constexpr int CW_SEAM = 32768, SEAM_BANK = 128 * 64;
static_assert((CW_SEAM + 7 * SEAM_BANK) * 4 <= (int)CTL_ZERO_BYTES, "CTL words inside the memset region");
constexpr int RING_OFF = 0, RING_BYTES = 131072;
constexpr int LDS_BYTES = 163840;
constexpr int LDSCTL_OFF = LDS_BYTES - 512, MISC_OFF = LDSCTL_OFF + 320;
#define GAS __attribute__((address_space(1)))
#define LAS __attribute__((address_space(3)))
typedef unsigned short bf16;
typedef unsigned v4u __attribute__((ext_vector_type(4)));
typedef float f32x4 __attribute__((ext_vector_type(4)));
typedef short bf16x8 __attribute__((ext_vector_type(8)));
typedef GAS unsigned gu32;
typedef GAS unsigned long long gu64;
#define RLX_AGENT __ATOMIC_RELAXED, __HIP_MEMORY_SCOPE_AGENT
#define LDS_WAIT() asm volatile("s_waitcnt lgkmcnt(0)" ::: "memory")
#define VM_WAIT() asm volatile("s_waitcnt vmcnt(0)" ::: "memory")
__device__ __forceinline__ unsigned long long rt() { return __builtin_amdgcn_s_memrealtime(); }
__device__ __forceinline__ unsigned f2bf(float f) { unsigned u = __builtin_bit_cast(unsigned, f); return (u + 0x7fffu + ((u >> 16) & 1u)) >> 16; }
__device__ __forceinline__ unsigned pk2(float lo, float hi) { return pg8::cvt_pk_bf16(lo, hi); }

#define XB_TMO      128
#define XB_XCNT(j)  (256  + 64 * (j))
#define XB_XSUB(j)  (1280 + 64 * (j))
#define XB_XGEN(j)  (2304 + 64 * (j))
#define XB_TOP      3328
#define XB_TOPGEN   3392
#define XCD_BAR_WORDS 3456
#define XB_SPIN_CAP (1u << 18)

__device__ __forceinline__ unsigned xb_ld(unsigned* p)              { return __hip_atomic_load(p, __ATOMIC_RELAXED, __HIP_MEMORY_SCOPE_AGENT); }
__device__ __forceinline__ unsigned xb_add(unsigned* p, unsigned v) { return __hip_atomic_fetch_add(p, v, __ATOMIC_RELAXED, __HIP_MEMORY_SCOPE_AGENT); }
__device__ __forceinline__ unsigned xb_xcc_id() { return (unsigned)__builtin_amdgcn_s_getreg((3 << 11) | 20) & 0xFu; }
#define XB_SPIN(cond, bar) do { unsigned _sp = 0; while (cond) { __builtin_amdgcn_s_sleep(1); \
    if ((++_sp & 255u) == 0u) { if (xb_ld(&(bar)[XB_TMO])) break; if (_sp > XB_SPIN_CAP) { atomicAdd(&(bar)[XB_TMO], 1u); break; } } } } while (0)

__device__ __forceinline__ int lane_id() { int l; asm volatile("v_mbcnt_lo_u32_b32 %0, -1, 0\n\tv_mbcnt_hi_u32_b32 %0, -1, %0" : "=v"(l)); return l; }
struct XcdBarrier {
    int wave; unsigned* bar; unsigned x;
    volatile LAS unsigned* st;
};

__device__ __forceinline__ XcdBarrier xcd_barrier_post(unsigned* bar, volatile LAS unsigned* st, int wave) {
    XcdBarrier b; b.bar = bar; b.x = xb_xcc_id(); b.st = st; b.wave = wave;
    if (wave == 0 && lane_id() == 0) (void)xb_add(&bar[XB_XCNT(b.x)], 1u);
    return b;
}
__device__ __forceinline__ void xcd_barrier_complete(unsigned* bar, unsigned x, unsigned& nloc, unsigned& nx) {
    const unsigned G = gridDim.x * gridDim.y * gridDim.z;
    unsigned sum, cnt, mine, sp = 0u;
    for (;;) {
        sum = 0u; cnt = 0u;
#pragma nounroll
        for (unsigned j = 0; j < 16; ++j) { const unsigned c = xb_ld(&bar[XB_XCNT(j)]); sum += c; cnt += (c > 0u) ? 1u : 0u; }
        if (sum == G) break;
        __builtin_amdgcn_s_sleep(1);
        if ((++sp & 255u) == 0u) { if (xb_ld(&bar[XB_TMO])) break; if (sp > XB_SPIN_CAP) { atomicAdd(&bar[XB_TMO], 1u); break; } }
    }
    mine = xb_ld(&bar[XB_XCNT(x)]);
    nloc = mine > 0u ? mine : 1u; nx = cnt > 0u ? cnt : 1u;
}

__device__ __forceinline__ void xcd_barrier(const XcdBarrier& b) {
    asm volatile("s_waitcnt vmcnt(0)" ::: "memory");
    __syncthreads();
    if (b.wave == 0 && lane_id() == 0) {
        unsigned* bar = b.bar;
        __builtin_amdgcn_s_waitcnt(0);
        unsigned nloc = b.st[0], nx = b.st[1];
        if (nloc == 0u) { xcd_barrier_complete(bar, b.x, nloc, nx); b.st[0] = nloc; b.st[1] = nx; }
        const unsigned old = xb_add(&bar[XB_XSUB(b.x)], 1u);
        const unsigned gen = old / nloc;
        if (old + 1u == (gen + 1u) * nloc) {
            __builtin_amdgcn_fence(__ATOMIC_RELEASE, "agent");
            asm volatile("s_waitcnt vmcnt(0)" ::: "memory");
            const unsigned og = xb_add(&bar[XB_TOP], 1u);
            const unsigned tg = og / nx;
            if (og + 1u == (tg + 1u) * nx) xb_add(&bar[XB_TOPGEN], 1u);
            else XB_SPIN(xb_ld(&bar[XB_TOPGEN]) == tg, bar);
            __builtin_amdgcn_fence(__ATOMIC_ACQUIRE, "agent");
            xb_add(&bar[XB_XGEN(b.x)], 1u);
            asm volatile("s_waitcnt vmcnt(0)" ::: "memory");
        } else {
            XB_SPIN(xb_ld(&bar[XB_XGEN(b.x)]) == gen, bar);
            __builtin_amdgcn_fence(__ATOMIC_ACQUIRE, "agent");
            asm volatile("s_waitcnt vmcnt(0)" ::: "memory");
        }
    }
    __syncthreads();
}
namespace mix {
typedef short bf16x8 __attribute__((ext_vector_type(8)));
typedef short s16x4 __attribute__((ext_vector_type(4)));
typedef float f32x4 __attribute__((ext_vector_type(4)));
typedef float f32x16 __attribute__((ext_vector_type(16)));
typedef unsigned u32x4 __attribute__((ext_vector_type(4)));
typedef unsigned u32x2 __attribute__((ext_vector_type(2)));
constexpr float LOG2E = 1.4426950408889634f;
__device__ __forceinline__ unsigned cvt2(float lo, float hi) { return pg8::cvt_pk_bf16(lo, hi); }
__device__ __forceinline__ float bflo(unsigned w) { return __uint_as_float(w << 16); }
__device__ __forceinline__ float bfhi(unsigned w) { return __uint_as_float(w & 0xffff0000u); }
__device__ __forceinline__ s16x4 tr16(LAS unsigned char* p) { typedef short v4i16_t __attribute__((ext_vector_type(4))); return __builtin_bit_cast(s16x4, __builtin_amdgcn_ds_read_tr16_b64_v4i16((LAS v4i16_t*)p)); }
__device__ __forceinline__ bf16x8 cat8(s16x4 a, s16x4 b) { return (bf16x8){a[0], a[1], a[2], a[3], b[0], b[1], b[2], b[3]}; }
__device__ __forceinline__ bf16x8 u4_to_b8(u32x4 w) { return __builtin_bit_cast(bf16x8, w); }

constexpr int AT_KROW = 144, AT_KEYS = 320, AT_LDS_K = 0, AT_LDS_V = AT_KEYS * AT_KROW;
__device__ __forceinline__ void attn_item(int item, LAS unsigned char* lds, const bf16* AQ, const bf16* AKV, bf16* ATT, const float* sink, int tid_in) {
    int tid = tid_in; asm volatile("" : "+v"(tid));
    const int lane = tid & 63, wid = __builtin_amdgcn_readfirstlane(tid >> 6), r32 = lane & 31, hi = lane >> 5;
    const int qb = item & 63, kvh = (item >> 6) & 1, b = item >> 7;
    const int q0 = qb * 64;
    const size_t rowbase = (size_t)b * SEQ;
#pragma unroll
    for (int i = 0; i < 5; ++i) { const int id = tid + 512 * i, key = id >> 3, c = id & 7; const int pos = q0 - 128 + key;
        if (pos >= 0 && pos < SEQ) { const bf16* src = AKV + (rowbase + pos) * 256 + kvh * 64 + c * 8;
            const u32x4 kk = *(const u32x4*)src, vv = *(const u32x4*)(src + 128);
            *(LAS u32x4*)(lds + AT_LDS_K + key * AT_KROW + c * 16) = kk;
            *(LAS u32x4*)(lds + AT_LDS_V + key * 128 + (((c >> 2) ^ ((key >> 1) & 1)) << 6) + (c & 3) * 16) = vv; } }
    const int g4 = wid & 3, rh = wid >> 2, hq = kvh * 4 + g4;
    const int qrow0 = q0 + 32 * rh;
    bf16x8 qf[4];
    { const bf16* qp = AQ + (rowbase + qrow0 + r32) * 512 + hq * 64 + hi * 8;
#pragma unroll
      for (int ks = 0; ks < 4; ++ks) qf[ks] = u4_to_b8(*(const u32x4*)(qp + ks * 16)); }
    const float sk = sink[hq] * LOG2E;
    float mrun = sk, lsum = (hi == 0) ? 1.0f : 0.0f;
    f32x16 o0 = {}, o1 = {};
    asm volatile("s_waitcnt vmcnt(0) lgkmcnt(0)" ::: "memory"); __builtin_amdgcn_s_barrier(); asm volatile("" ::: "memory");
#pragma nounroll
    for (int t = 0; t < 9; ++t) {
        const int kpos0 = qrow0 - 128 + 32 * t;
        if (kpos0 < 0 || kpos0 >= SEQ) continue;
        const int kl0 = 32 * rh + 32 * t;
        f32x16 s = {};
        { LAS unsigned char* kp = lds + AT_LDS_K + (kl0 + r32) * AT_KROW + hi * 16;
#pragma unroll
          for (int ks = 0; ks < 4; ++ks) { const bf16x8 kf = *(LAS bf16x8*)(kp + ks * 32); s = __builtin_amdgcn_mfma_f32_32x32x16_bf16(kf, qf[ks], s, 0, 0, 0); } }
        if (t == 0) {
#pragma unroll
            for (int i = 0; i < 16; ++i) { const int c = (i & 3) + 8 * (i >> 2) + 4 * hi; if (c < r32) s[i] = -INFINITY; }
        } else if (t == 8) {
#pragma unroll
            for (int i = 0; i < 16; ++i) { const int c = (i & 3) + 8 * (i >> 2) + 4 * hi; if (c > r32) s[i] = -INFINITY; }
        }
        float tm = s[0];
#pragma unroll
        for (int i = 1; i < 16; ++i) tm = fmaxf(tm, s[i]);
        tm = fmaxf(tm, __shfl_xor(tm, 32));
        if (__any(tm > mrun)) {
            const float mnew = fmaxf(mrun, tm), alpha = __builtin_amdgcn_exp2f(mrun - mnew);
            mrun = mnew; lsum *= alpha;
#pragma unroll
            for (int i = 0; i < 16; ++i) { o0[i] *= alpha; o1[i] *= alpha; }
        }
        float ps = 0.f;
#pragma unroll
        for (int i = 0; i < 16; ++i) { s[i] = __builtin_amdgcn_exp2f(s[i] - mrun); ps += s[i]; }
        lsum += ps;
        bf16x8 pf[2];
#pragma unroll
        for (int ks = 0; ks < 2; ++ks) { u32x4 w; w.x = cvt2(s[8 * ks + 0], s[8 * ks + 1]); w.y = cvt2(s[8 * ks + 2], s[8 * ks + 3]); w.z = cvt2(s[8 * ks + 4], s[8 * ks + 5]); w.w = cvt2(s[8 * ks + 6], s[8 * ks + 7]); pf[ks] = u4_to_b8(w); }
        { const int li = lane & 15, q = li >> 2, p = li & 3, dsel = (lane >> 4) & 1;
#pragma unroll
          for (int ks = 0; ks < 2; ++ks) {
#pragma unroll
            for (int dt = 0; dt < 2; ++dt) {
                const int key_a = kl0 + 16 * ks + 4 * hi + q, key_b = key_a + 8;
                LAS unsigned char* pa = lds + AT_LDS_V + key_a * 128 + ((dt ^ ((key_a >> 1) & 1)) << 6) + dsel * 32 + p * 8;
                LAS unsigned char* pb = lds + AT_LDS_V + key_b * 128 + ((dt ^ ((key_b >> 1) & 1)) << 6) + dsel * 32 + p * 8;
                const bf16x8 vf = cat8(tr16(pa), tr16(pb));
                if (dt == 0) o0 = __builtin_amdgcn_mfma_f32_32x32x16_bf16(vf, pf[ks], o0, 0, 0, 0);
                else         o1 = __builtin_amdgcn_mfma_f32_32x32x16_bf16(vf, pf[ks], o1, 0, 0, 0); } } }
    }
    lsum += __shfl_xor(lsum, 32);
    const float il = 1.0f / lsum;
    bf16* op = ATT + (rowbase + qrow0 + r32) * 512 + hq * 64 + 4 * hi;
#pragma unroll
    for (int gq = 0; gq < 4; ++gq) {
        u32x2 w0, w1; w0.x = cvt2(o0[4 * gq] * il, o0[4 * gq + 1] * il); w0.y = cvt2(o0[4 * gq + 2] * il, o0[4 * gq + 3] * il);
        w1.x = cvt2(o1[4 * gq] * il, o1[4 * gq + 1] * il); w1.y = cvt2(o1[4 * gq + 2] * il, o1[4 * gq + 3] * il);
        *(u32x2*)(op + 8 * gq) = w0; *(u32x2*)(op + 32 + 8 * gq) = w1; }
    asm volatile("s_waitcnt lgkmcnt(0)" ::: "memory"); __builtin_amdgcn_s_barrier(); asm volatile("" ::: "memory");
}

__device__ __forceinline__ void attn_run(int item0, int istep, int nitems, LAS unsigned char* lds, const bf16* AQ, const bf16* AKV, bf16* ATT, const float* sink, int tid_in) {
    int tid = tid_in; asm volatile("" : "+v"(tid));
    const int lane = tid & 63, wid = __builtin_amdgcn_readfirstlane(tid >> 6), r32 = lane & 31, hi = lane >> 5;
    u32x4 pk[5], pv[5];
#define AT_LOADKV(it_) do { const int qb_ = (it_) & 63, kvh_ = ((it_) >> 6) & 1, b_ = (it_) >> 7; \
        _Pragma("unroll") for (int i = 0; i < 5; ++i) { const int id = tid + 512 * i, key = id >> 3, c = id & 7; const int pos = qb_ * 64 - 128 + key; \
            if (pos >= 0 && pos < SEQ) { const bf16* src = AKV + ((size_t)b_ * SEQ + pos) * 256 + kvh_ * 64 + c * 8; pk[i] = *(const u32x4*)src; pv[i] = *(const u32x4*)(src + 128); } } } while (0)
    if (item0 < nitems) AT_LOADKV(item0);
#pragma nounroll
    for (int item = item0; item < nitems; item += istep) {
    const int qb = item & 63, kvh = (item >> 6) & 1, b = item >> 7;
    const int q0 = qb * 64;
    const size_t rowbase = (size_t)b * SEQ;
#pragma unroll
    for (int i = 0; i < 5; ++i) { const int id = tid + 512 * i, key = id >> 3, c = id & 7; const int pos = q0 - 128 + key;
        if (pos >= 0 && pos < SEQ) {
            *(LAS u32x4*)(lds + AT_LDS_K + key * AT_KROW + c * 16) = pk[i];
            *(LAS u32x4*)(lds + AT_LDS_V + key * 128 + (((c >> 2) ^ ((key >> 1) & 1)) << 6) + (c & 3) * 16) = pv[i]; } }
    const int g4 = wid & 3, rh = wid >> 2, hq = kvh * 4 + g4;
    const int qrow0 = q0 + 32 * rh;
    bf16x8 qf[4];
    { const bf16* qp = AQ + (rowbase + qrow0 + r32) * 512 + hq * 64 + hi * 8;
#pragma unroll
      for (int ks = 0; ks < 4; ++ks) qf[ks] = u4_to_b8(*(const u32x4*)(qp + ks * 16)); }
    if (item + istep < nitems) AT_LOADKV(item + istep);
    const float sk = sink[hq] * LOG2E;
    float mrun = sk, lsum = (hi == 0) ? 1.0f : 0.0f;
    f32x16 o0 = {}, o1 = {};
    asm volatile("s_waitcnt lgkmcnt(0)" ::: "memory"); __builtin_amdgcn_s_barrier(); asm volatile("" ::: "memory");
#pragma nounroll
    for (int t = 0; t < 9; ++t) {
        const int kpos0 = qrow0 - 128 + 32 * t;
        if (kpos0 < 0 || kpos0 >= SEQ) continue;
        const int kl0 = 32 * rh + 32 * t;
        f32x16 s = {};
        { LAS unsigned char* kp = lds + AT_LDS_K + (kl0 + r32) * AT_KROW + hi * 16;
#pragma unroll
          for (int ks = 0; ks < 4; ++ks) { const bf16x8 kf = *(LAS bf16x8*)(kp + ks * 32); s = __builtin_amdgcn_mfma_f32_32x32x16_bf16(kf, qf[ks], s, 0, 0, 0); } }
        if (t == 0) {
#pragma unroll
            for (int i = 0; i < 16; ++i) { const int c = (i & 3) + 8 * (i >> 2) + 4 * hi; if (c < r32) s[i] = -INFINITY; }
        } else if (t == 8) {
#pragma unroll
            for (int i = 0; i < 16; ++i) { const int c = (i & 3) + 8 * (i >> 2) + 4 * hi; if (c > r32) s[i] = -INFINITY; }
        }
        float tm = s[0];
#pragma unroll
        for (int i = 1; i < 16; ++i) tm = fmaxf(tm, s[i]);
        tm = fmaxf(tm, __shfl_xor(tm, 32));
        if (__any(tm > mrun)) {
            const float mnew = fmaxf(mrun, tm), alpha = __builtin_amdgcn_exp2f(mrun - mnew);
            mrun = mnew; lsum *= alpha;
#pragma unroll
            for (int i = 0; i < 16; ++i) { o0[i] *= alpha; o1[i] *= alpha; }
        }
        float ps = 0.f;
#pragma unroll
        for (int i = 0; i < 16; ++i) { s[i] = __builtin_amdgcn_exp2f(s[i] - mrun); ps += s[i]; }
        lsum += ps;
        bf16x8 pf[2];
#pragma unroll
        for (int ks = 0; ks < 2; ++ks) { u32x4 w; w.x = cvt2(s[8 * ks + 0], s[8 * ks + 1]); w.y = cvt2(s[8 * ks + 2], s[8 * ks + 3]); w.z = cvt2(s[8 * ks + 4], s[8 * ks + 5]); w.w = cvt2(s[8 * ks + 6], s[8 * ks + 7]); pf[ks] = u4_to_b8(w); }
        { const int li = lane & 15, q = li >> 2, p = li & 3, dsel = (lane >> 4) & 1;
#pragma unroll
          for (int ks = 0; ks < 2; ++ks) {
#pragma unroll
            for (int dt = 0; dt < 2; ++dt) {
                const int key_a = kl0 + 16 * ks + 4 * hi + q, key_b = key_a + 8;
                LAS unsigned char* pa = lds + AT_LDS_V + key_a * 128 + ((dt ^ ((key_a >> 1) & 1)) << 6) + dsel * 32 + p * 8;
                LAS unsigned char* pb = lds + AT_LDS_V + key_b * 128 + ((dt ^ ((key_b >> 1) & 1)) << 6) + dsel * 32 + p * 8;
                const bf16x8 vf = cat8(tr16(pa), tr16(pb));
                if (dt == 0) o0 = __builtin_amdgcn_mfma_f32_32x32x16_bf16(vf, pf[ks], o0, 0, 0, 0);
                else         o1 = __builtin_amdgcn_mfma_f32_32x32x16_bf16(vf, pf[ks], o1, 0, 0, 0); } } }
    }
    lsum += __shfl_xor(lsum, 32);
    const float il = 1.0f / lsum;
    bf16* op = ATT + (rowbase + qrow0 + r32) * 512 + hq * 64 + 8 * hi;
#pragma unroll
    for (int gp = 0; gp < 2; ++gp) {
#pragma unroll
        for (int hf = 0; hf < 2; ++hf) {
            unsigned ax, ay, bx_, by_;
            if (hf == 0) { ax = cvt2(o0[8 * gp] * il, o0[8 * gp + 1] * il); ay = cvt2(o0[8 * gp + 2] * il, o0[8 * gp + 3] * il); bx_ = cvt2(o0[8 * gp + 4] * il, o0[8 * gp + 5] * il); by_ = cvt2(o0[8 * gp + 6] * il, o0[8 * gp + 7] * il); }
            else         { ax = cvt2(o1[8 * gp] * il, o1[8 * gp + 1] * il); ay = cvt2(o1[8 * gp + 2] * il, o1[8 * gp + 3] * il); bx_ = cvt2(o1[8 * gp + 4] * il, o1[8 * gp + 5] * il); by_ = cvt2(o1[8 * gp + 6] * il, o1[8 * gp + 7] * il); }
            { auto r = __builtin_amdgcn_permlane32_swap(ax, bx_, false, false); ax = r[0]; bx_ = r[1]; }
            { auto r = __builtin_amdgcn_permlane32_swap(ay, by_, false, false); ay = r[0]; by_ = r[1]; }
            u32x4 w; w.x = ax; w.y = ay; w.z = bx_; w.w = by_;
            *(u32x4*)(op + 32 * hf + 16 * gp) = w; } }
    asm volatile("s_waitcnt lgkmcnt(0)" ::: "memory"); __builtin_amdgcn_s_barrier(); asm volatile("" ::: "memory");
    }
#undef AT_LOADKV
}

constexpr int ML_BUF = 49152, ML_Q = 0, ML_K = 16384, ML_V = 32768, ML_SC = 98304, ML_ARR = 106496, ML_ARRP = 2560;
constexpr int MA_A = 0, MA_M = 256, MA_WI = 512, MA_EN = 768, MA_WK = 1024, MA_SCAL = 1280;
constexpr int MB_DEN = 2 * ML_ARRP, MB_QN = MB_DEN + 512, MB_NV = MB_QN + 256;
__device__ __forceinline__ int swc(int row) { return (row & 3) | (((row >> 3) & 1) << 2); }
__device__ __forceinline__ int ml_off(int row, int dim) { return row * 256 + (((dim >> 4) ^ swc(row)) << 5) + (dim & 15) * 2; }
__device__ __forceinline__ int sc_off(int j, int t) { return j * 128 + ((((t >> 3)) ^ ((j >> 1) & 7)) << 4) + (t & 7) * 2; }
__device__ __forceinline__ float dppf(float old, float src, const int ctrl_sel) {
    const int o = __float_as_int(old), v = __float_as_int(src); int r;
    switch (ctrl_sel) {
        case 1: r = __builtin_amdgcn_update_dpp(o, v, 0x111, 0xf, 0xf, false); break;
        case 2: r = __builtin_amdgcn_update_dpp(o, v, 0x112, 0xf, 0xf, false); break;
        case 4: r = __builtin_amdgcn_update_dpp(o, v, 0x114, 0xf, 0xf, false); break;
        case 8: r = __builtin_amdgcn_update_dpp(o, v, 0x118, 0xf, 0xf, false); break;
        case 15: r = __builtin_amdgcn_update_dpp(o, v, 0x142, 0xa, 0xf, false); break;
        default: r = __builtin_amdgcn_update_dpp(o, v, 0x143, 0xc, 0xf, false); break;
    }
    return __int_as_float(r);
}
__device__ __forceinline__ float wave_scan_add(float x) { x += dppf(0.f, x, 1); x += dppf(0.f, x, 2); x += dppf(0.f, x, 4); x += dppf(0.f, x, 8); x += dppf(0.f, x, 15); x += dppf(0.f, x, 31); return x; }
__device__ __forceinline__ float wave_scan_max(float x) { const float ni = -INFINITY; x = fmaxf(x, dppf(ni, x, 1)); x = fmaxf(x, dppf(ni, x, 2)); x = fmaxf(x, dppf(ni, x, 4)); x = fmaxf(x, dppf(ni, x, 8)); x = fmaxf(x, dppf(ni, x, 15)); x = fmaxf(x, dppf(ni, x, 31)); return x; }
constexpr int M3_Q = 0, M3_K = 49152, M3_V = 98304, M3_SC = 131072, M3_ARR = 147456, M3_ARRS = 1536, M3_DEN = 152064, M3_QN = 152576, M3_NV = 152832, M3_FLAG = 153344, M3_END = 153600;
template <int MODE = 0>
__device__ __forceinline__ void mlstm_item3(int item, LAS unsigned char* lds, const bf16* CQK, const bf16* MV, const float* GATES, bf16* HSF, bf16* HSB, int tid_in) {
    int tid = tid_in; asm volatile("" : "+v"(tid));
    const int lane = tid & 63, wid = __builtin_amdgcn_readfirstlane(tid >> 6), l15 = lane & 15, g = lane >> 4;
    const int dvh = item & 1, dir = (item >> 1) & 1, h = (item >> 2) & 3, b = item >> 4;
    bf16* HS = dir ? HSB : HSF;
    const size_t rowbase = (size_t)b * SEQ;
    LAS float* aDEN = (LAS float*)(lds + M3_DEN); LAS float* aQN = (LAS float*)(lds + M3_QN); LAS float* aNV = (LAS float*)(lds + M3_NV); LAS unsigned* aFLAG = (LAS unsigned*)(lds + M3_FLAG);
#define M3_GROW(c, row) (rowbase + (size_t)(dir ? (SEQ - 1 - (64 * (c) + (row))) : (64 * (c) + (row))))
#define M3_BAR() do { asm volatile("s_waitcnt lgkmcnt(0)" ::: "memory"); __builtin_amdgcn_s_barrier(); asm volatile("" ::: "memory"); } while (0)
    if (tid < 128) aNV[tid] = 0.f;
    __builtin_amdgcn_s_waitcnt(0);
    if (tid < 4) aFLAG[tid] = 0u;
    if (wid >= 4) {
        const int tt_ = tid - 256;
        u32x4 pqA[4], pkA[4], pvA[4], pqB[4], pkB[4], pvB[4]; float gliA = 0.f, glfA = 0.f, gliB = 0.f, glfB = 0.f, m_prev = 0.f;
        int wo_, tq_[4], tw_[4];
        unsigned lo_ = (unsigned)(((dir ? 63 - (tt_ >> 4) : (tt_ >> 4)) * 1024 + (tt_ & 15) * 8) * 2), go_ = (unsigned)((dir ? 63 - lane : lane) * 64);
        asm volatile("" : "+v"(lo_), "+v"(go_));
        { const int swl = swc(l15), s2 = (l15 >> 1) & 7;
          wo_ = ml_off(tt_ >> 4, (tt_ & 15) * 8);
#pragma unroll
          for (int ks = 0; ks < 4; ++ks) tq_[ks] = l15 * 256 + (((2 * ks + (g >> 1)) ^ swl) << 5) + (g & 1) * 16;
#pragma unroll
          for (int tt = 0; tt < 4; ++tt) tw_[tt] = l15 * 128 + (((2 * tt + (g >> 1)) ^ s2) << 4) + (g & 1) * 8;
          asm volatile("" : "+v"(wo_));
#pragma unroll
          for (int k = 0; k < 4; ++k) asm volatile("" : "+v"(tq_[k]), "+v"(tw_[k])); }
#define M3_CBASE(c) ((size_t)(rowbase + (size_t)(dir ? SEQ - 64 * ((c) + 1) : 64 * (c))))
#define M3_LOAD_QK(c, S) do { const char* qb_ = (const char*)(CQK + M3_CBASE(c) * 1024 + h * 128); _Pragma("unroll") for (int i = 0; i < 4; ++i) { const char* p_ = qb_ + (dir ? -32768 * i : 32768 * i); \
            pq##S[i] = *(const u32x4*)(p_ + lo_); pk##S[i] = *(const u32x4*)(p_ + 1024 + lo_); } } while (0)
#define M3_LOAD_V(c, S) do { const char* vb_ = (const char*)(MV + M3_CBASE(c) * 1024 + h * 256 + dvh * 128); _Pragma("unroll") for (int i = 0; i < 4; ++i) { \
            pv##S[i] = *(const u32x4*)(vb_ + (dir ? -32768 * i : 32768 * i) + lo_); } } while (0)
#define M3_LOAD_G(c, S) do { const char* gb_ = (const char*)(GATES + M3_CBASE(c) * 16 + dir * 8 + h); gli##S = *(const float*)(gb_ + go_); glf##S = *(const float*)(gb_ + 16 + go_); } while (0)
#define M3_WRITE_QK(c, S) do { const int qo_ = ((c) % 3) * 16384; _Pragma("unroll") for (int i = 0; i < 4; ++i) { const int off = qo_ + wo_ + 4096 * i; \
            *(LAS u32x4*)(lds + M3_Q + off) = pq##S[i]; *(LAS u32x4*)(lds + M3_K + off) = pk##S[i]; } } while (0)
#define M3_WRITE_V(c, S) do { const int vo_ = ((c) & 1) * 16384; _Pragma("unroll") for (int i = 0; i < 4; ++i) { \
            *(LAS u32x4*)(lds + M3_V + vo_ + wo_ + 4096 * i) = pv##S[i]; } } while (0)
#define M3_GATES(c, S) do { if (wid == 7) { LAS float* A_ = (LAS float*)(lds + M3_ARR + ((c) % 3) * M3_ARRS); \
            const float bsum = wave_scan_add(glf##S); const float a = gli##S - bsum; const float pm = wave_scan_max(a); const float Mj = fmaxf(m_prev, pm); \
            const float M63 = __shfl(Mj, 63), b63 = __shfl(bsum, 63); \
            A_[MA_A / 4 + lane] = a * LOG2E; A_[MA_M / 4 + lane] = Mj * LOG2E; A_[MA_WI / 4 + lane] = __builtin_amdgcn_exp2f((m_prev - Mj) * LOG2E); A_[MA_EN / 4 + lane] = __builtin_amdgcn_exp2f(-(bsum + Mj) * LOG2E); \
            A_[MA_WK / 4 + lane] = __builtin_amdgcn_exp2f((a - M63) * LOG2E); if (lane == 0) A_[MA_SCAL / 4] = __builtin_amdgcn_exp2f((m_prev - M63) * LOG2E); \
            m_prev = b63 + M63; } } while (0)
#define M3_SCORE_ROWS(c, jt) do { const int qo_ = ((c) % 3) * 16384; LAS float* A_ = (LAS float*)(lds + M3_ARR + ((c) % 3) * M3_ARRS); const int j = 16 * (jt) + l15; \
            bf16x8 qb_[4]; _Pragma("unroll") for (int ks = 0; ks < 4; ++ks) qb_[ks] = *(LAS bf16x8*)(lds + M3_Q + qo_ + tq_[ks] + 4096 * (jt)); \
            const float Mj = A_[MA_M / 4 + j]; float rs = 0.f; \
            _Pragma("unroll") for (int tt = 0; tt < 4; ++tt) { f32x4 sc = {0.f, 0.f, 0.f, 0.f}; \
                if (tt <= (jt)) { f32x4 d = {0.f, 0.f, 0.f, 0.f}; const int trow = 16 * tt + l15; \
                    _Pragma("unroll") for (int ks = 0; ks < 4; ++ks) { const bf16x8 kf = *(LAS bf16x8*)(lds + M3_K + qo_ + tq_[ks] + 4096 * tt); d = __builtin_amdgcn_mfma_f32_16x16x32_bf16(kf, qb_[ks], d, 0, 0, 0); } \
                    const f32x4 a4 = *(LAS f32x4*)(A_ + MA_A / 4 + 16 * tt + 4 * g); \
                    _Pragma("unroll") for (int r = 0; r < 4; ++r) { const int t = 16 * tt + 4 * g + r; const float w = (t <= j) ? __builtin_amdgcn_exp2f(a4[r] - Mj) : 0.f; sc[r] = d[r] * w; rs += sc[r]; } } \
                u32x2 pk_; pk_.x = cvt2(sc[0], sc[1]); pk_.y = cvt2(sc[2], sc[3]); \
                *(LAS u32x2*)(lds + M3_SC + ((c) & 1) * 8192 + tw_[tt] + 2048 * (jt)) = pk_; } \
            rs += __shfl_xor(rs, 16); rs += __shfl_xor(rs, 32); \
            if (g == 0) aDEN[64 * ((c) & 1) + j] = rs; } while (0)
#define M3_SCORES(c) do { if (wid == 4) M3_SCORE_ROWS(c, 3); else if (wid == 5) M3_SCORE_ROWS(c, 2); else if (wid == 6) { M3_SCORE_ROWS(c, 1); M3_SCORE_ROWS(c, 0); } } while (0)
        if (MODE != 2) { M3_LOAD_QK(0, A); M3_LOAD_V(0, A); M3_LOAD_G(0, A); M3_WRITE_QK(0, A); M3_WRITE_V(0, A); M3_GATES(0, A);
        M3_LOAD_QK(1, A); M3_LOAD_G(1, A); M3_WRITE_QK(1, A); M3_GATES(1, A);
        M3_LOAD_QK(2, A); M3_LOAD_G(2, A); M3_LOAD_V(1, A); M3_LOAD_QK(3, B); M3_LOAD_G(3, B); M3_LOAD_V(2, B); }
        M3_BAR();
        if (MODE != 2) M3_SCORES(0);
        M3_BAR();
#define M3_TSTEP(c, S) do { \
            if ((c) + 2 < 64) M3_WRITE_QK((c) + 2, S); \
            if ((c) + 1 < 64) M3_WRITE_V((c) + 1, S); \
            if ((c) + 2 < 64) M3_GATES((c) + 2, S); \
            if ((c) + 4 < 64) { M3_LOAD_QK((c) + 4, S); M3_LOAD_G((c) + 4, S); } \
            if ((c) + 3 < 64) M3_LOAD_V((c) + 3, S); \
            if ((c) + 1 < 64) M3_SCORES((c) + 1); \
            M3_BAR(); } while (0)
#pragma nounroll
        for (int c = 0; c < 64; c += 2) {
            if (MODE == 2) { M3_BAR(); M3_BAR(); continue; }
            M3_TSTEP(c, A);
            M3_TSTEP(c + 1, B);
        }
#undef M3_TSTEP
    } else {
        const int s_ = wid;
        f32x4 C[8][2]; f32x4 nst[2] = {{0.f, 0.f, 0.f, 0.f}, {0.f, 0.f, 0.f, 0.f}};
#pragma unroll
        for (int T = 0; T < 8; ++T) { C[T][0] = (f32x4){0.f, 0.f, 0.f, 0.f}; C[T][1] = (f32x4){0.f, 0.f, 0.f, 0.f}; }
        M3_BAR();
        M3_BAR();
        const int q4 = l15 >> 2, p4 = l15 & 3;
        int qA[4], qB[4], kT[8], kN[2], sK[2], hoff;
        { const int swl = swc(l15), swt = q4 | ((g & 1) << 2), s2 = (l15 >> 1) & 7;
#pragma unroll
          for (int ks = 0; ks < 4; ++ks) { qA[ks] = l15 * 256 + (((2 * ks) ^ swl) << 5) + 8 * g; qB[ks] = l15 * 256 + (((2 * ks + 1) ^ swl) << 5) + 8 * g; }
#pragma unroll
          for (int T = 0; T < 8; ++T) kT[T] = (8 * g + q4) * 256 + ((T ^ swt) << 5) + 8 * p4;
#pragma unroll
          for (int tn = 0; tn < 2; ++tn) kN[tn] = (8 * g + q4) * 256 + (((2 * s_ + tn) ^ swt) << 5) + 8 * p4;
#pragma unroll
          for (int ks = 0; ks < 2; ++ks) sK[ks] = l15 * 128 + (((4 * ks + g) ^ s2) << 4);
          hoff = (dir ? 15 - l15 : l15) * 2048 + 8 * g;
#pragma unroll
          for (int ks = 0; ks < 4; ++ks) asm volatile("" : "+v"(qA[ks]), "+v"(qB[ks]));
#pragma unroll
          for (int T = 0; T < 8; ++T) asm volatile("" : "+v"(kT[T]));
          asm volatile("" : "+v"(kN[0]), "+v"(kN[1]), "+v"(sK[0]), "+v"(sK[1]), "+v"(hoff)); }
#pragma nounroll
        for (int c = 0; c < 64; ++c) {
            if (MODE == 1) { M3_BAR(); continue; }
            const int qo = (c % 3) * 16384, vo = (c & 1) * 16384, par = c & 1;
            LAS float* A_ = (LAS float*)(lds + M3_ARR + (c % 3) * M3_ARRS);
            LAS unsigned char* const Qb = lds + M3_Q + qo; LAS unsigned char* const Kb = lds + M3_K + qo; LAS unsigned char* const Vb = lds + M3_V + vo; LAS unsigned char* const Sb = lds + M3_SC + par * 8192;
            { f32x4 qn = {0.f, 0.f, 0.f, 0.f};
#pragma unroll
              for (int ks = 0; ks < 4; ++ks) {
                  const u32x2 a0 = *(LAS u32x2*)(Qb + s_ * 4096 + qA[ks]), a1 = *(LAS u32x2*)(Qb + s_ * 4096 + qB[ks]);
                  const f32x4 n0 = *(LAS f32x4*)(aNV + 32 * ks + 4 * g), n1 = *(LAS f32x4*)(aNV + 32 * ks + 16 + 4 * g);
                  u32x4 aw; aw.x = a0.x; aw.y = a0.y; aw.z = a1.x; aw.w = a1.y;
                  u32x4 bw; bw.x = cvt2(n0[0], n0[1]); bw.y = cvt2(n0[2], n0[3]); bw.z = cvt2(n1[0], n1[1]); bw.w = cvt2(n1[2], n1[3]);
                  qn = __builtin_amdgcn_mfma_f32_16x16x32_bf16(u4_to_b8(aw), u4_to_b8(bw), qn, 0, 0, 0); }
              if (l15 == 0) *(LAS f32x4*)(aQN + 16 * s_ + 4 * g) = qn;
              asm volatile("s_waitcnt lgkmcnt(0)" ::: "memory");
              if (lane == 0) aFLAG[s_] = (unsigned)(c + 1);
              asm volatile("" ::: "memory"); }
            bf16x8 vb[2][2], Cb[4][2];
#pragma unroll
            for (int nt = 0; nt < 2; ++nt) {
#pragma unroll
                for (int ks = 0; ks < 2; ++ks) vb[ks][nt] = cat8(tr16(Vb + kN[nt] + ks * 8192), tr16(Vb + kN[nt] + ks * 8192 + 1024));
#pragma unroll
                for (int ks = 0; ks < 4; ++ks) { u32x4 w; w.x = cvt2(C[2 * ks][nt][0], C[2 * ks][nt][1]); w.y = cvt2(C[2 * ks][nt][2], C[2 * ks][nt][3]); w.z = cvt2(C[2 * ks + 1][nt][0], C[2 * ks + 1][nt][1]); w.w = cvt2(C[2 * ks + 1][nt][2], C[2 * ks + 1][nt][3]); Cb[ks][nt] = u4_to_b8(w); } }
#pragma unroll
            for (int mt = 0; mt < 4; ++mt) { const int j = 16 * mt + l15;
                f32x4 sv[2] = {{0.f, 0.f, 0.f, 0.f}, {0.f, 0.f, 0.f, 0.f}}, in[2] = {{0.f, 0.f, 0.f, 0.f}, {0.f, 0.f, 0.f, 0.f}};
#pragma unroll
                for (int ks = 0; ks < 2; ++ks) if (ks == 0 || mt >= 2) { const bf16x8 af = *(LAS bf16x8*)(Sb + sK[ks] + mt * 2048);
                    sv[0] = __builtin_amdgcn_mfma_f32_16x16x32_bf16(vb[ks][0], af, sv[0], 0, 0, 0); sv[1] = __builtin_amdgcn_mfma_f32_16x16x32_bf16(vb[ks][1], af, sv[1], 0, 0, 0); }
#pragma unroll
                for (int ks = 0; ks < 4; ++ks) {
                    const u32x2 a0 = *(LAS u32x2*)(Qb + qA[ks] + mt * 4096), a1 = *(LAS u32x2*)(Qb + qB[ks] + mt * 4096);
                    u32x4 aw; aw.x = a0.x; aw.y = a0.y; aw.z = a1.x; aw.w = a1.y;
                    in[0] = __builtin_amdgcn_mfma_f32_16x16x32_bf16(Cb[ks][0], u4_to_b8(aw), in[0], 0, 0, 0); in[1] = __builtin_amdgcn_mfma_f32_16x16x32_bf16(Cb[ks][1], u4_to_b8(aw), in[1], 0, 0, 0); }
                if (mt == 0) {
                    for (;;) { asm volatile("" ::: "memory"); const u32x4 f = *(LAS u32x4*)aFLAG; const unsigned mn = min(min(f.x, f.y), min(f.z, f.w));
                        if (__builtin_amdgcn_readfirstlane((int)mn) >= c + 1) break; __builtin_amdgcn_s_sleep(1); } }
                const float wi = A_[MA_WI / 4 + j], den = aDEN[64 * par + j] + wi * aQN[j];
                const float inv = __builtin_amdgcn_rcpf(fmaxf(fabsf(den), A_[MA_EN / 4 + j]));
                char* const ub = (char*)(HS + (rowbase + (size_t)(dir ? SEQ - 16 - (64 * c + 16 * mt) : 64 * c + 16 * mt)) * 1024 + h * 256 + dvh * 128 + 32 * s_);
#pragma unroll
                for (int nt = 0; nt < 2; ++nt) { u32x2 o; o.x = cvt2((sv[nt][0] + wi * in[nt][0]) * inv, (sv[nt][1] + wi * in[nt][1]) * inv); o.y = cvt2((sv[nt][2] + wi * in[nt][2]) * inv, (sv[nt][3] + wi * in[nt][3]) * inv);
                    *(u32x2*)(ub + (unsigned)hoff + 32 * nt) = o; } }
            { const float decay = A_[MA_SCAL / 4];
              bf16x8 vw[2][2]; bf16x8 wkb[2];
#pragma unroll
              for (int ks = 0; ks < 2; ++ks) { const f32x4 w0 = *(LAS f32x4*)(A_ + MA_WK / 4 + 32 * ks + 8 * g), w1 = *(LAS f32x4*)(A_ + MA_WK / 4 + 32 * ks + 8 * g + 4);
#pragma unroll
                  for (int nt = 0; nt < 2; ++nt) { const u32x4 v = __builtin_bit_cast(u32x4, vb[ks][nt]); u32x4 o;
                      o.x = cvt2(bflo(v.x) * w0[0], bfhi(v.x) * w0[1]); o.y = cvt2(bflo(v.y) * w0[2], bfhi(v.y) * w0[3]); o.z = cvt2(bflo(v.z) * w1[0], bfhi(v.z) * w1[1]); o.w = cvt2(bflo(v.w) * w1[2], bfhi(v.w) * w1[3]);
                      vw[ks][nt] = u4_to_b8(o); }
                  u32x4 wk; wk.x = cvt2(w0[0], w0[1]); wk.y = cvt2(w0[2], w0[3]); wk.z = cvt2(w1[0], w1[1]); wk.w = cvt2(w1[2], w1[3]); wkb[ks] = u4_to_b8(wk); }
              f32x4 nacc[2] = {{0.f, 0.f, 0.f, 0.f}, {0.f, 0.f, 0.f, 0.f}};
#pragma unroll
              for (int tn = 0; tn < 2; ++tn)
#pragma unroll
                  for (int ks = 0; ks < 2; ++ks) { const bf16x8 kf = cat8(tr16(Kb + kN[tn] + ks * 8192), tr16(Kb + kN[tn] + ks * 8192 + 1024));
                      nacc[tn] = __builtin_amdgcn_mfma_f32_16x16x32_bf16(kf, wkb[ks], nacc[tn], 0, 0, 0); }
#pragma unroll
              for (int T = 0; T < 8; ++T) { C[T][0] = C[T][0] * decay; C[T][1] = C[T][1] * decay;
#pragma unroll
                  for (int ks = 0; ks < 2; ++ks) { const bf16x8 kf = cat8(tr16(Kb + kT[T] + ks * 8192), tr16(Kb + kT[T] + ks * 8192 + 1024));
                      C[T][0] = __builtin_amdgcn_mfma_f32_16x16x32_bf16(kf, vw[ks][0], C[T][0], 0, 0, 0); C[T][1] = __builtin_amdgcn_mfma_f32_16x16x32_bf16(kf, vw[ks][1], C[T][1], 0, 0, 0); } }
#pragma unroll
              for (int tn = 0; tn < 2; ++tn) { nst[tn] = nst[tn] * decay + nacc[tn]; if (l15 == 0) *(LAS f32x4*)(aNV + 16 * (2 * s_ + tn) + 4 * g) = nst[tn]; } }
            M3_BAR();
        }
    }
#undef M3_GROW
#undef M3_BAR
#undef M3_LOAD_QK
#undef M3_CBASE
#undef M3_LOAD_V
#undef M3_LOAD_G
#undef M3_WRITE_QK
#undef M3_WRITE_V
#undef M3_GATES
#undef M3_SCORE_ROWS
#undef M3_SCORES
}
}
struct Args { const float* in[25]; float* out; unsigned char* ws; int ph_lo, ph_hi, li, pad; };
__device__ __forceinline__ float wave_sum(float v) {
#pragma unroll
    for (int o = 1; o < 64; o <<= 1) v += __shfl_xor(v, o);
    return v;
}
__device__ __forceinline__ int colmap(int map, int n) {
    if (map == 1) { const int pn = n >> 8, r = n & 255; return (r >> 7) * FFN + 128 * pn + (r & 127); }
    if (map == 2) { if (n >= 3840) return (n < 3856) ? n : -1;
                    if (n < 640 && (n & 63) < 16) { const int p = n & 15; return (n - p) + 4 * (p >> 3) + 8 * ((p >> 2) & 1) + (p & 3); } return n; }
    if (map == 3) return 3856 + n;
    return n;
}
__device__ __forceinline__ float colscale(int map, int n) {
    if (map == 1) return ((n & 255) < 128) ? -1.4426950408889634f : -0.6931471805599453f;
    if (map == 2) return (n >= 2816 && n < 3840) ? -1.4426950408889634f : 1.0f;
    if (map == 3 || map == 4) return -1.4426950408889634f;
    return 1.0f;
}
__device__ __forceinline__ void p0_item3(const float* __restrict__ W, int K, int Nsrc, int Ndst, bf16* __restrict__ WT, const float* __restrict__ gain, int map, int item, int lane_, LAS float* T) {
    const int nblk = Ndst / 64, kb = item / nblk, nb = item % nblk, k0 = 64 * kb, n0 = 64 * nb;
    const int c4 = lane_ & 15, kr = lane_ >> 4;
    const int sc = colmap(map, n0 + 4 * c4); const float cs = colscale(map, n0 + 4 * c4);
    f32x4 v[16];
#pragma unroll
    for (int i = 0; i < 16; ++i) { v[i] = (f32x4){0.f, 0.f, 0.f, 0.f}; if (sc >= 0) v[i] = *(const GAS f32x4*)(W + (size_t)(k0 + 4 * i + kr) * Nsrc + sc); }
#pragma unroll
    for (int i = 0; i < 16; ++i) { const int k = 4 * i + kr; float g = cs; if (gain) g = gain[k0 + k] * cs;
        *(LAS f32x4*)(T + k * 64 + ((c4 ^ ((k >> 3) & 7)) << 2)) = v[i] * g; }
    LDS_WAIT(); asm volatile("" ::: "memory");
    const int oct = lane_ & 7;
#pragma unroll
    for (int j = 0; j < 8; ++j) { const int n = (lane_ >> 3) + 8 * j; const int col = (((n >> 2) ^ oct) << 2) | (n & 3);
        const LAS float* t = T + (8 * oct) * 64 + col;
        v4u o; o.x = pk2(t[0], t[64]); o.y = pk2(t[128], t[192]); o.z = pk2(t[256], t[320]); o.w = pk2(t[384], t[448]);
        *(GAS v4u*)(WT + (size_t)(n0 + n) * K + k0 + 8 * oct) = o; }
    LDS_WAIT(); asm volatile("" ::: "memory");
}
__global__ void __launch_bounds__(NWAVES * 64, 2) mk_fwd(Args args) {
    extern __shared__ __attribute__((aligned(16))) unsigned char lds[];
    LAS unsigned char* const L = (LAS unsigned char*)lds;
    volatile LAS unsigned* const MISC = (volatile LAS unsigned*)(L + MISC_OFF);
    const int wave = __builtin_amdgcn_readfirstlane((int)threadIdx.x >> 6);
#define tid (wave * 64 + lane_id())
#define lane (lane_id())
    const int G = gridDim.x; const int bx = blockIdx.x; const int vcu = (G % 8 == 0) ? (bx % 8) * (G / 8) + bx / 8 : bx;
    unsigned char* const ws = args.ws;
    gu32* const ctl = (gu32*)(ws + WS_CTL);
    for (int u = tid; u < (LDS_BYTES - LDSCTL_OFF) / 4; u += NWAVES * 64) ((LAS unsigned*)(L + LDSCTL_OFF))[u] = 0u;
    __syncthreads();
    XcdBarrier bar = xcd_barrier_post((unsigned*)(ctl + CW_BAR) + args.li * XCD_BAR_WORDS, MISC + 8, wave);
    const int lo = args.ph_lo, hi = args.ph_hi;
    bf16* const XN = (bf16*)(ws + WS_XN);
    float* const INV = (float*)(ws + WS_SSQ);
    float* const ROPE_C = (float*)(ws + WS_ROPE); float* const ROPE_S = ROPE_C + SEQ * 8;
    const int gw = vcu * NWAVES + wave, NGW = G * NWAVES;

#define IN(k) (lo <= (k) && (k) < hi)
#define SEAM(k) do { if (lo <= (k) && (k) + 1 < hi) xcd_barrier(bar); } while (0)
    if (IN(0)) {
        {
        {
            struct WD { int src; int K, Nsrc, Ndst; size_t dst; int gain; int map; };
            const WD wd[11] = { {3, 1024, 5632, 5632, WS_W1A, 2, 1}, {4, 2816, 1024, 1024, WS_W2A, -1, 0}, {7, 1024, INW, 4096, WS_WINA, 6, 2}, {7, 1024, INW, 2048, WS_WINB, 6, 3},
                                {13, 512, 1024, 1024, WS_WBA, -1, 0}, {14, 1024, 1024, 1024, WS_WBM, -1, 0}, {15, 1024, 1024, 1024, WS_WOUT, -1, 0},
                                {18, 1024, 5632, 5632, WS_W1B, 17, 1}, {19, 2816, 1024, 1024, WS_W2B, -1, 0}, {22, 1024, 1024, 1024, WS_WPG, 21, 4}, {23, 256, 1024, 1024, WS_WPP, -1, 0} };
            int base_it = 0;
            LAS float* Tw = (LAS float*)(L + RING_OFF + wave * 16384);
#pragma unroll
            for (int w = 0; w < 11; ++w) { const int ni = (wd[w].K / 64) * (wd[w].Ndst / 64);
                int first = gw - (base_it % NGW); if (first < 0) first += NGW;
                for (int r = first; r < ni; r += NGW)
                    p0_item3(args.in[wd[w].src], wd[w].K, wd[w].Nsrc, wd[w].Ndst, (bf16*)(ws + wd[w].dst), wd[w].gain >= 0 ? args.in[wd[w].gain] : nullptr, wd[w].map, r, lane, Tw);
                base_it += ni; }
        }
        {
            {
                const float* x = args.in[0];
                for (int m0 = gw * 4; m0 < M; m0 += NGW * 4) {
                    f32x4 v[4][4];
#pragma unroll
                    for (int rr = 0; rr < 4; ++rr) { const GAS f32x4* xr = (const GAS f32x4*)(x + (size_t)(m0 + rr) * DM) + lane;
#pragma unroll
                        for (int j = 0; j < 4; ++j) v[rr][j] = xr[64 * j]; }
#pragma unroll
                    for (int rr = 0; rr < 4; ++rr) { float s = 0.f;
#pragma unroll
                        for (int j = 0; j < 4; ++j) s += (v[rr][j].x * v[rr][j].x + v[rr][j].y * v[rr][j].y) + (v[rr][j].z * v[rr][j].z + v[rr][j].w * v[rr][j].w);
                        s = wave_sum(s);
                        const float r = rsqrtf(s * (1.f / 1024.f) + pg8::RMS_EPS);
                        if (lane == 0) INV[m0 + rr] = 1.0f / r;
                        GAS unsigned long long* o8 = (GAS unsigned long long*)(XN + (size_t)(m0 + rr) * DM) + lane;
#pragma unroll
                        for (int j = 0; j < 4; ++j) o8[64 * j] = (unsigned long long)pk2(v[rr][j].x * r, v[rr][j].y * r) | ((unsigned long long)pk2(v[rr][j].z * r, v[rr][j].w * r) << 32); }
                } }
        }
        {
            { const float* p = args.in[1]; bf16* PB = (bf16*)(ws + WS_PB);
                const size_t NP = (size_t)M * PLE_DIM / 4, stride = (size_t)NGW * 64;
                for (size_t i0 = (size_t)(gw * 64 + lane); i0 < NP; i0 += 4 * stride) { f32x4 v[4];
#pragma unroll
                    for (int k = 0; k < 4; ++k) if (i0 + k * stride < NP) v[k] = *(const GAS f32x4*)(p + (i0 + k * stride) * 4);
#pragma unroll
                    for (int k = 0; k < 4; ++k) if (i0 + k * stride < NP) *(GAS unsigned long long*)(PB + (i0 + k * stride) * 4) = (unsigned long long)pk2(v[k].x, v[k].y) | ((unsigned long long)pk2(v[k].z, v[k].w) << 32); } }
        }
        {
            {
                for (int i = bx * (NWAVES * 64) + tid; i < (int)(4 * MiB / 16); i += G * NWAVES * 64) ((GAS v4u*)(ws + WS_XBUF))[i] = (v4u){0u, 0u, 0u, 0u}; }
            {
                const int t = bx * (NWAVES * 64) + tid;
                if ((t & 3) == 0 && (t >> 2) < SEQ * 8) { const int i = t >> 2, pos = i >> 3, j = i & 7;
                    const float invs[8] = {(float)1.0, (float)0.19392274474868576, (float)0.03760603093086393, (float)0.007292664737217109, (float)0.001414213562373095, (float)0.0002742481756762073, (float)5.318295896944988e-05, (float)1.031338537721246e-05};
                    float inv = invs[0];
#pragma unroll
                    for (int k = 1; k < 8; ++k) inv = (j == k) ? invs[k] : inv;
                    const float ang = (float)pos * inv;
                    ROPE_C[i] = (float)cos((double)ang); ROPE_S[i] = (float)sin((double)ang); } }
        }
        }
    }
    SEAM(0);
    if (IN(1)) { pg8::Gemm g{XN, (const bf16*)(ws + WS_W1A), M, 2 * FFN, DM}; pg8::StaticOrder S; S.init(M, 2 * FFN, G, bx);
        pg8::EpiSwiglu E{(bf16*)(ws + WS_H)};
        pg8::gemm_phase<DM, pg8::EpiSwiglu, pg8::StaticOrder, true, true>(L + RING_OFF, g, S, E, wave);
        }
#ifdef PROBE_G2
    { xcd_barrier(bar);
        pg8::Gemm g{(const bf16*)(ws + WS_H), (const bf16*)(ws + WS_W2A), M, DM, FFN}; pg8::StaticOrder S; S.init(M, DM, G, bx);
        pg8::EpiSwigluT<2> E{(bf16*)(ws + WS_H)};
        pg8::gemm_phase<FFN, pg8::EpiSwigluT<2>, pg8::StaticOrder, true, true>(L + RING_OFF, g, S, E, wave); }
    { xcd_barrier(bar);
        pg8::Gemm g{(const bf16*)(ws + WS_H), (const bf16*)(ws + WS_W2A), M, DM, FFN}; pg8::StaticOrder S; S.init(M, DM, G, bx);
        pg8::EpiSwigluT<2> E{(bf16*)(ws + WS_H)};
        pg8::gemm_phase<FFN, pg8::EpiSwigluT<2>, pg8::StaticOrder, true, true>(L + RING_OFF, g, S, E, wave); }
#endif
#ifdef PROBE_G1
    { xcd_barrier(bar);
        pg8::Gemm g{XN, (const bf16*)(ws + WS_W1A), M, 2 * FFN, DM}; pg8::StaticOrder S; S.init(M, 2 * FFN, G, bx);
        pg8::EpiSwigluT<PROBE_G1 - 1> E{(bf16*)(ws + WS_H)};
        pg8::gemm_phase<DM, pg8::EpiSwigluT<PROBE_G1 - 1>, pg8::StaticOrder, true, true>(L + RING_OFF, g, S, E, wave); }
    { xcd_barrier(bar);
        pg8::Gemm g{XN, (const bf16*)(ws + WS_W1A), M, 2 * FFN, DM}; pg8::StaticOrder S; S.init(M, 2 * FFN, G, bx);
        pg8::EpiSwigluT<PROBE_G1 - 1> E{(bf16*)(ws + WS_H)};
        pg8::gemm_phase<DM, pg8::EpiSwigluT<PROBE_G1 - 1>, pg8::StaticOrder, true, true>(L + RING_OFF, g, S, E, wave); }
#endif
    SEAM(1);
    if (IN(2)) { const unsigned poison = (unsigned)__builtin_amdgcn_readfirstlane((int)(__hip_atomic_load(ctl + CW_TMO, RLX_AGENT) != 0u));
        pg8::Gemm g{(const bf16*)(ws + WS_H), (const bf16*)(ws + WS_W2A), M, DM, FFN};
#pragma nounroll
        for (int rd = 0; rd < 2; ++rd) { pg8::PanelSsq st{(unsigned*)(ws + WS_XBUF), (unsigned*)(ctl + CW_SEAM), (unsigned*)(ctl + CW_TMO), 0x700u}, st2{(unsigned*)(ws + WS_XBUF) + (size_t)4 * M * 4, (unsigned*)(ctl + CW_SEAM + 4 * SEAM_BANK), (unsigned*)(ctl + CW_TMO), 0x800u}; pg8::EpiRmsRes E{XN, INV, INV + M, args.in[5], 0.5f, st, st2, poison};
            pg8::RoundOrder S; S.so.init(M, DM, G, bx); S.round = rd;
            pg8::gemm_phase<FFN, pg8::EpiRmsRes, pg8::RoundOrder, false, true>(L + RING_OFF, g, S, E, wave); __syncthreads(); } }
    SEAM(2);
    if (IN(3)) { pg8::Gemm g{XN, (const bf16*)(ws + WS_WINA), M, 4096, DM}; pg8::StaticOrder S; S.init(M, 4096, G, bx);
        pg8::EpiRoute E{(bf16*)(ws + WS_AQ), (bf16*)(ws + WS_AKV), (bf16*)(ws + WS_MQK), (bf16*)(ws + WS_MV), (bf16*)(ws + WS_MO), (float*)(ws + WS_GATES), ROPE_C, ROPE_S, args.in[8]};
        pg8::gemm_phase<DM, pg8::EpiRoute, pg8::StaticOrder, true, true>(L + RING_OFF, g, S, E, wave); }
    SEAM(3);
    if (IN(4)) {
            const bf16* MQK = (const bf16*)(ws + WS_MQK); bf16* CQK = (bf16*)(ws + WS_CQK); const float* cw = args.in[9]; const float* cb = args.in[10];
            for (int it = bx * (NWAVES * 64) + tid; it < (M / 16) * 128; it += G * NWAVES * 64) {
                const int cg = it & 127, rb = it >> 7, c0 = cg * 8, r0 = rb * 16, s0 = r0 & (SEQ - 1);
                pg8::u32x4 raw[20];
#pragma unroll
                for (int i = 0; i < 20; ++i) { const int sp = s0 - 2 + i; raw[i] = (pg8::u32x4){0u, 0u, 0u, 0u}; if (sp >= 0 && sp < SEQ) raw[i] = *(const pg8::u32x4*)(MQK + (size_t)(r0 - 2 + i) * 1024 + c0); }
                float wgt[5][8], bias[8];
#pragma unroll
                for (int j = 0; j < 5; ++j) { const f32x4 a = *(const f32x4*)(cw + j * 1024 + c0), b = *(const f32x4*)(cw + j * 1024 + c0 + 4);
                    wgt[j][0] = a[0]; wgt[j][1] = a[1]; wgt[j][2] = a[2]; wgt[j][3] = a[3]; wgt[j][4] = b[0]; wgt[j][5] = b[1]; wgt[j][6] = b[2]; wgt[j][7] = b[3]; }
                { const f32x4 a = *(const f32x4*)(cb + c0), b = *(const f32x4*)(cb + c0 + 4); bias[0] = a[0]; bias[1] = a[1]; bias[2] = a[2]; bias[3] = a[3]; bias[4] = b[0]; bias[5] = b[1]; bias[6] = b[2]; bias[7] = b[3]; }
                const float osc = (c0 >= 512) ? 0.08838834764831845f : 1.0f;
#pragma unroll
                for (int o = 0; o < 16; ++o) { float acc8[8];
#pragma unroll
                    for (int e = 0; e < 8; ++e) acc8[e] = bias[e];
#pragma unroll
                    for (int j = 0; j < 5; ++j) { pg8::f32x4 a, b; pg8::unpack8(raw[o + j], a, b);
#pragma unroll
                        for (int e = 0; e < 4; ++e) { acc8[e] += a[e] * wgt[j][e]; acc8[4 + e] += b[e] * wgt[j][4 + e]; } }
                    pg8::f32x4 o0, o1;
#pragma unroll
                    for (int e = 0; e < 4; ++e) { o0[e] = acc8[e] * pg8::fsigmoid(acc8[e]) * osc; o1[e] = acc8[4 + e] * pg8::fsigmoid(acc8[4 + e]) * osc; }
                    *(pg8::u32x4*)(CQK + (size_t)(r0 + o) * 1024 + c0) = pg8::pack8(o0, o1); }
            }
    }
    SEAM(4);
    if (IN(5)) {
#ifdef PROBE_ML
        if (bx < 128) mix::mlstm_item3<PROBE_ML>(((((bx >> 3) >> 1) * 8 + (bx & 7)) << 1) | ((bx >> 3) & 1), L, (const bf16*)(ws + WS_CQK), (const bf16*)(ws + WS_MV), (const float*)(ws + WS_GATES), (bf16*)(ws + WS_HSF), (bf16*)(ws + WS_HSB), tid);
        xcd_barrier(bar);
#endif
#ifdef PROBE_AT
        if (bx >= 128) mix::attn_run(((bx - 128) & 7) * 16 + ((bx - 128) >> 3), G - 128, 1024, L, (const bf16*)(ws + WS_AQ), (const bf16*)(ws + WS_AKV), (bf16*)(ws + WS_T1), args.in[11], tid);
        xcd_barrier(bar);
#endif
        const int mitem = ((((bx >> 3) >> 1) * 8 + (bx & 7)) << 1) | ((bx >> 3) & 1);
        if (bx < 128) { mix::mlstm_item3(mitem, L, (const bf16*)(ws + WS_CQK), (const bf16*)(ws + WS_MV), (const float*)(ws + WS_GATES), (bf16*)(ws + WS_HSF), (bf16*)(ws + WS_HSB), tid);
            { const int grp = mitem >> 2, qtr = mitem & 3; gu32* cnt = ctl + CW_HMG + 64 * grp;
              VM_WAIT(); __syncthreads();
              if (tid == 0) { __builtin_amdgcn_fence(__ATOMIC_RELEASE, "agent"); VM_WAIT(); __hip_atomic_fetch_add(cnt, 1u, RLX_AGENT);
                  unsigned sp = 0; while (__hip_atomic_load(cnt, RLX_AGENT) < 4u) { __builtin_amdgcn_s_sleep(8); if (++sp > (1u << 22)) { __hip_atomic_store(ctl + CW_TMO, 1u, RLX_AGENT); break; } }
                  __builtin_amdgcn_fence(__ATOMIC_ACQUIRE, "agent"); VM_WAIT(); }
              __syncthreads();
              const bf16* HSF = (const bf16*)(ws + WS_HSF); const bf16* HSB = (const bf16*)(ws + WS_HSB); bf16* HM = (bf16*)(ws + WS_HM); const float* gn = args.in[12];
              const int hh = grp & 3; const size_t rb0 = (size_t)(grp >> 2) * SEQ + qtr * 1024 + wave * 128;
              const int hl = lane & 31, rsel = lane >> 5;
              const pg8::f32x4 gg0 = *(const pg8::f32x4*)(gn + hh * 256 + hl * 8), gg1 = *(const pg8::f32x4*)(gn + hh * 256 + hl * 8 + 4);
#pragma nounroll
              for (int r0 = 0; r0 < 128; r0 += 16) {
                  pg8::u32x4 qa[8], qb[8], qg[8];
#pragma unroll
                  for (int i = 0; i < 8; ++i) { const size_t o = (rb0 + r0 + 2 * i + rsel) * 1024 + hh * 256 + hl * 8;
                      qa[i] = *(const pg8::u32x4*)(HSF + o); qb[i] = *(const pg8::u32x4*)(HSB + o); qg[i] = *(const pg8::u32x4*)(HM + o); }
#pragma unroll
                  for (int i = 0; i < 8; ++i) { pg8::f32x4 a0, a1, b0, b1, g0, g1; pg8::unpack8(qa[i], a0, a1); pg8::unpack8(qb[i], b0, b1); pg8::unpack8(qg[i], g0, g1);
                      const pg8::f32x4 v0 = a0 + b0, v1 = a1 + b1;
                      float ss = ((v0[0] * v0[0] + v0[1] * v0[1]) + (v0[2] * v0[2] + v0[3] * v0[3])) + ((v1[0] * v1[0] + v1[1] * v1[1]) + (v1[2] * v1[2] + v1[3] * v1[3]));
#pragma unroll
                      for (int o = 1; o < 32; o <<= 1) ss += __shfl_xor(ss, o);
                      const float r = rsqrtf(ss * (1.f / 256.f) + pg8::RMS_EPS);
                      *(pg8::u32x4*)(HM + (rb0 + r0 + 2 * i + rsel) * 1024 + hh * 256 + hl * 8) = pg8::pack8(v0 * r * gg0 * g0, v1 * r * gg1 * g1); }
              } }
            pg8::Gemm g{XN, (const bf16*)(ws + WS_WINB), M, 2048, DM}; pg8::QueueOrder S; S.so.init(M, 2048, 1, 0); S.xlab = bx & 7; S.ctr = (unsigned*)(ctl + CW_G3BQ + 64 * (bx & 7)); S.limit = 1024; S.slot = (LAS int*)(L + 131072 + 12288); S.wave = wave;
            pg8::EpiSig E{(bf16*)args.out, (bf16*)args.out + (size_t)M * 1024};
            pg8::gemm_phase<DM, pg8::EpiSig, pg8::QueueOrder, true, true>(L + RING_OFF, g, S, E, wave); }
        if (bx >= 128) { mix::attn_run(((bx - 128) & 7) * 16 + ((bx - 128) >> 3), G - 128, 1024, L, (const bf16*)(ws + WS_AQ), (const bf16*)(ws + WS_AKV), (bf16*)(ws + WS_AQ), args.in[11], tid);
            pg8::Gemm g{XN, (const bf16*)(ws + WS_WINB), M, 2048, DM}; pg8::QueueOrder S; S.so.init(M, 2048, 1, 0); S.xlab = bx & 7; S.ctr = (unsigned*)(ctl + CW_G3BQ + 64 * (bx & 7)); S.limit = 1024; S.slot = (LAS int*)(L + 131072 + 12288); S.wave = wave;
            pg8::EpiSig E{(bf16*)args.out, (bf16*)args.out + (size_t)M * 1024};
            pg8::gemm_phase<DM, pg8::EpiSig, pg8::QueueOrder, true, true>(L + RING_OFF, g, S, E, wave); }
    }
    SEAM(5);
    if (IN(8)) {
        { pg8::Gemm g{(const bf16*)(ws + WS_AQ), (const bf16*)(ws + WS_WBA), M, DM, 512}; pg8::StaticOrder S; S.init(M, DM, G, bx);
          pg8::EpiMul<false> E{(bf16*)(ws + WS_T1), (const bf16*)args.out, nullptr};
          pg8::gemm_phase<512, pg8::EpiMul<false>, pg8::StaticOrder, true, true>(L + RING_OFF, g, S, E, wave); }
        VM_WAIT(); __syncthreads();
        { pg8::Gemm g{(const bf16*)(ws + WS_HM), (const bf16*)(ws + WS_WBM), M, DM, DM}; pg8::StaticOrder S; S.init(M, DM, G, bx);
          pg8::EpiMul<true> E{(bf16*)(ws + WS_MG), (const bf16*)args.out + (size_t)M * 1024, (const bf16*)(ws + WS_T1)};
          pg8::gemm_phase<DM, pg8::EpiMul<true>, pg8::StaticOrder, true, true>(L + RING_OFF, g, S, E, wave); } }
    SEAM(8);
    if (IN(9)) { const unsigned poison = (unsigned)__builtin_amdgcn_readfirstlane((int)(__hip_atomic_load(ctl + CW_TMO, RLX_AGENT) != 0u));
        pg8::Gemm g{(const bf16*)(ws + WS_MG), (const bf16*)(ws + WS_WOUT), M, DM, DM};
#pragma nounroll
        for (int rd = 0; rd < 2; ++rd) { pg8::PanelSsq st{(unsigned*)(ws + WS_XBUF) + (size_t)1 * M * 4, (unsigned*)(ctl + CW_SEAM + 1 * SEAM_BANK), (unsigned*)(ctl + CW_TMO), 0x740u}, st2{(unsigned*)(ws + WS_XBUF) + (size_t)5 * M * 4, (unsigned*)(ctl + CW_SEAM + 5 * SEAM_BANK), (unsigned*)(ctl + CW_TMO), 0x840u}; pg8::EpiRmsRes E{XN, INV + M, INV + 2 * M, args.in[16], 1.0f, st, st2, poison};
            pg8::RoundOrder S; S.so.init(M, DM, G, bx); S.round = rd;
            pg8::gemm_phase<DM, pg8::EpiRmsRes, pg8::RoundOrder, false, true>(L + RING_OFF, g, S, E, wave); __syncthreads(); } }
    SEAM(9);
    if (IN(10)) { pg8::Gemm g{XN, (const bf16*)(ws + WS_W1B), M, 2 * FFN, DM}; pg8::StaticOrder S; S.init(M, 2 * FFN, G, bx);
        pg8::EpiSwiglu E{(bf16*)(ws + WS_H)};
        pg8::gemm_phase<DM, pg8::EpiSwiglu, pg8::StaticOrder, true, true>(L + RING_OFF, g, S, E, wave); }
    SEAM(10);
    if (IN(11)) { const unsigned poison = (unsigned)__builtin_amdgcn_readfirstlane((int)(__hip_atomic_load(ctl + CW_TMO, RLX_AGENT) != 0u));
        pg8::Gemm g{(const bf16*)(ws + WS_H), (const bf16*)(ws + WS_W2B), M, DM, FFN};
#pragma nounroll
        for (int rd = 0; rd < 2; ++rd) { pg8::PanelSsq st{(unsigned*)(ws + WS_XBUF) + (size_t)2 * M * 4, (unsigned*)(ctl + CW_SEAM + 2 * SEAM_BANK), (unsigned*)(ctl + CW_TMO), 0x780u}, st2{(unsigned*)(ws + WS_XBUF) + (size_t)6 * M * 4, (unsigned*)(ctl + CW_SEAM + 6 * SEAM_BANK), (unsigned*)(ctl + CW_TMO), 0x880u}; pg8::EpiRmsRes E{XN, INV + 2 * M, INV + 3 * M, args.in[20], 0.5f, st, st2, poison};
            pg8::RoundOrder S; S.so.init(M, DM, G, bx); S.round = rd;
            pg8::gemm_phase<FFN, pg8::EpiRmsRes, pg8::RoundOrder, false, true>(L + RING_OFF, g, S, E, wave); __syncthreads(); } }
    SEAM(11);
    if (IN(12)) {
        { pg8::Gemm g{(const bf16*)(ws + WS_PB), (const bf16*)(ws + WS_WPP), M, DM, PLE_DIM}; pg8::StaticOrder S; S.init(M, DM, G, bx);
          pg8::EpiPlainNP E{(bf16*)(ws + WS_PR)};
          pg8::gemm_phase<PLE_DIM, pg8::EpiPlainNP, pg8::StaticOrder, true, true>(L + RING_OFF, g, S, E, wave); }
        VM_WAIT(); __syncthreads();
        const unsigned poison = (unsigned)__builtin_amdgcn_readfirstlane((int)(__hip_atomic_load(ctl + CW_TMO, RLX_AGENT) != 0u));
        pg8::Gemm g{XN, (const bf16*)(ws + WS_WPG), M, DM, DM};
#pragma nounroll
        for (int rd = 0; rd < 2; ++rd) { pg8::PanelSsq st{(unsigned*)(ws + WS_XBUF) + (size_t)3 * M * 4, (unsigned*)(ctl + CW_SEAM + 3 * SEAM_BANK), (unsigned*)(ctl + CW_TMO), 0x7c0u}; pg8::EpiPle E{XN, INV + 3 * M, args.out, (const bf16*)(ws + WS_PR), args.in[24], st, poison};
            pg8::RoundOrder S; S.so.init(M, DM, G, bx); S.round = rd;
            pg8::gemm_phase<DM, pg8::EpiPle, pg8::RoundOrder, false, true>(L + RING_OFF, g, S, E, wave); __syncthreads(); } }
#undef IN
#undef tid
#undef lane
#undef SEAM
}
extern "C" void kernel_launch(void* const* d_in, const int* in_sizes, int n_in, void* d_out, int out_size, void* d_ws, size_t ws_size, hipStream_t stream) {
    static int grid = 0;
    if (grid == 0) {
        if (n_in != 25 || in_sizes[0] != M * DM || out_size != M * DM || ws_size < WS_END) { fprintf(stderr, "kernel_launch: unexpected shapes (n_in %d, in0 %d, out %d, ws %zu)\n", n_in, n_in > 0 ? in_sizes[0] : -1, out_size, ws_size); grid = -1; return; }
        int dev = 0, cus = 0, per_cu = 0;
        if (hipGetDevice(&dev) != hipSuccess || hipDeviceGetAttribute(&cus, hipDeviceAttributeMultiprocessorCount, dev) != hipSuccess) { grid = -1; return; }
        if (hipFuncSetAttribute((const void*)mk_fwd, hipFuncAttributeMaxDynamicSharedMemorySize, LDS_BYTES) != hipSuccess) { fprintf(stderr, "kernel_launch: hipFuncSetAttribute failed\n"); grid = -1; return; }
        if (hipOccupancyMaxActiveBlocksPerMultiprocessor(&per_cu, (const void*)mk_fwd, NWAVES * 64, LDS_BYTES) != hipSuccess || per_cu < 1) { fprintf(stderr, "kernel_launch: occupancy query says %d\n", per_cu); per_cu = 1; }
        (void)hipGetLastError();
        grid = cus;
        if (grid != 256) fprintf(stderr, "kernel_launch: %d CUs; the fused epilogues need a 256-workgroup grid\n", grid);
    }
    if (grid < 0) return;
    (void)hipMemsetAsync((char*)d_ws + WS_CTL, 0, CTL_ZERO_BYTES, stream);
    Args a{};
    for (int i = 0; i < 25; ++i) a.in[i] = (const float*)d_in[i];
    a.out = (float*)d_out; a.ws = (unsigned char*)d_ws;
    a.ph_lo = 0; a.ph_hi = 13; a.li = 0;
    hipLaunchKernelGGL(mk_fwd, dim3(grid), dim3(NWAVES * 64), LDS_BYTES, stream, a);
}
```

```cpp
#include <hip/hip_runtime.h>
#include <cstdio>
#include <cstdint>
namespace pg8 {
#define PG8_LAS __attribute__((address_space(3)))
typedef unsigned short bf16_t;
typedef short bf16x8 __attribute__((ext_vector_type(8)));
typedef float f32x4 __attribute__((ext_vector_type(4)));
typedef unsigned u32x4 __attribute__((ext_vector_type(4)));
constexpr int BM = 256, BK = 64, HALF = 128, HTB = HALF * BK * 2  , STAGE_BYTES = 8 * HTB, NXCD = 8, WGM = 8;

__host__ __device__ __forceinline__ int lds_byte(int r, int c) { const int st = (r >> 4) * 2 + (c >> 5), rr = r & 15, cc = c & 31, ob = rr * 64 + cc * 2; return st * 1024 + (ob ^ (((ob >> 9) & 1) << 5)); }
__host__ __device__ __forceinline__ void stage_rc(int b, int& R, int& C) { const int st = b / 1024, sb = b % 1024, swz = sb ^ (((sb >> 9) & 1) << 5); R = (st >> 1) * 16 + swz / 64; C = (st & 1) * 32 + (swz % 64) / 2; }
__host__ __device__ __forceinline__ int perm32(int rho) { const int n = rho >> 4, i = rho & 15; return 8 * (i >> 2) + 4 * n + (i & 3); }

struct Unit { int pm, pn; };
struct Gemm { const bf16_t* A; const bf16_t* Bt; int M, N, K; };

struct StaticOrder {
    int nM, nN, nwg, G, c;
    __host__ __device__ void init(int M, int N, int G_, int c_) { nM = M / BM; nN = N / BM; nwg = nM * nN; G = G_; c = c_; }
    __host__ __device__ bool next(int i, Unit& u) const {
        const long L = (long)i * G + c; if (L >= nwg) return false;
        int wgid = (int)L; { const int q = nwg / NXCD, r = nwg % NXCD, xcd = wgid % NXCD, off = wgid / NXCD; wgid = (xcd < r ? xcd * (q + 1) : r * (q + 1) + (xcd - r) * q) + off; }
        const int nig = WGM * nN, gid = wgid / nig, fm = gid * WGM, gsz = (nM - fm) < WGM ? (nM - fm) : WGM;
        u.pm = fm + ((wgid % nig) % gsz); u.pn = (wgid % nig) / gsz; return true;
    }
    __device__ __forceinline__ void a_ready(const Unit&) const {}
    __device__ __forceinline__ void done(const Unit&) const {}
};

typedef float f32x2 __attribute__((ext_vector_type(2)));
typedef __bf16 bf16x2_t __attribute__((ext_vector_type(2)));
__device__ __forceinline__ unsigned cvt_pk_bf16(float lo, float hi) { const f32x2 v = {lo, hi}; const bf16x2_t b = __builtin_convertvector(v, bf16x2_t); return __builtin_bit_cast(unsigned, b); }
typedef unsigned u32x2 __attribute__((ext_vector_type(2)));
constexpr float RMS_EPS = 1e-6f, LOG2E = 1.4426950408889634f, QSCALE = 0.125f * 1.4426950408889634f;
__device__ __forceinline__ float bf_lo(unsigned w) { return __uint_as_float(w << 16); }
__device__ __forceinline__ float bf_hi(unsigned w) { return __uint_as_float(w & 0xffff0000u); }
__device__ __forceinline__ float fsigmoid(float x) { return __builtin_amdgcn_rcpf(1.f + __builtin_amdgcn_exp2f(-LOG2E * x)); }
__device__ __forceinline__ float fsig2(float xs) { return __builtin_amdgcn_rcpf(1.f + __builtin_amdgcn_exp2f(xs)); }
__device__ __forceinline__ u32x4 pack8(const f32x4 a, const f32x4 b) { u32x4 w; w.x = cvt_pk_bf16(a[0], a[1]); w.y = cvt_pk_bf16(a[2], a[3]); w.z = cvt_pk_bf16(b[0], b[1]); w.w = cvt_pk_bf16(b[2], b[3]); return w; }
__device__ __forceinline__ u32x2 pack4(const f32x4 a) { u32x2 w; w.x = cvt_pk_bf16(a[0], a[1]); w.y = cvt_pk_bf16(a[2], a[3]); return w; }
__device__ __forceinline__ void unpack8(const u32x4 w, f32x4& a, f32x4& b) { a = (f32x4){bf_lo(w.x), bf_hi(w.x), bf_lo(w.y), bf_hi(w.y)}; b = (f32x4){bf_lo(w.z), bf_hi(w.z), bf_lo(w.w), bf_hi(w.w)}; }
__device__ __forceinline__ f32x4 unpack4(const u32x2 w) { return (f32x4){bf_lo(w.x), bf_hi(w.x), bf_lo(w.y), bf_hi(w.y)}; }

template <int mode> struct EpiSwigluT { static constexpr bool PERM = true, AFTER_DRAIN = false;
    bf16_t* H;
    __device__ __forceinline__ void operator()(const f32x4 (&acc)[2][2][4][2], const Unit& u, int wr, int wc, int fr, int fq) const {
        const int row0 = u.pm * BM + wr * 64 + fr, col0 = u.pn * HALF + wc * 32 + 8 * fq;
        if (mode == 2) { f32x4 t = {0.f, 0.f, 0.f, 0.f};
#pragma unroll
            for (int ai = 0; ai < 2; ++ai)
#pragma unroll
                for (int bj = 0; bj < 2; ++bj)
#pragma unroll
                    for (int m = 0; m < 4; ++m) t += acc[ai][bj][m][0] + acc[ai][bj][m][1];
            if (t[0] + t[1] + t[2] + t[3] == 1.2345678e-30f) *(float*)(H + (size_t)row0 * 2816 + col0) = t[0];
            return; }
#pragma unroll
        for (int ai = 0; ai < 2; ++ai)
#pragma unroll
            for (int m = 0; m < 4; ++m) { const int row = row0 + ai * HALF + m * 16;
                f32x4 h0, h1;
#pragma unroll
                for (int j = 0; j < 4; ++j) { const float g0 = acc[ai][0][m][0][j], g1 = acc[ai][0][m][1][j]; h0[j] = g0 * fsig2(g0) * acc[ai][1][m][0][j]; h1[j] = g1 * fsig2(g1) * acc[ai][1][m][1][j]; }
                if (mode == 0) *(u32x4*)(H + (size_t)row * 2816 + col0) = pack8(h0, h1);
                else if (mode == 1) { const u32x4 w = pack8(h0, h1); if ((w.x ^ w.y ^ w.z ^ w.w) == 0x12345679u) *(u32x4*)(H + (size_t)row * 2816 + col0) = w; } }
    }
};
typedef EpiSwigluT<0> EpiSwiglu;
struct EpiRoute { static constexpr bool PERM = true, AFTER_DRAIN = false;
    bf16_t *AQ, *AKV, *MQK, *MV, *MO; float* GATES; const float* cs; const float* sn; const float* bgate;
    __device__ __forceinline__ void operator()(const f32x4 (&acc)[2][2][4][2], const Unit& u, int wr, int wc, int fr, int fq) const {
        const int pn = u.pn, row0 = u.pm * BM + wr * 64 + fr, cw = wc * 32 + 8 * fq;
        if (pn <= 2) {
            const bool rope_lane = (wc & 1) == 0 && fq < 2;
#pragma unroll
            for (int ai = 0; ai < 2; ++ai) {
                f32x4 cc[4], ss[4];
#pragma unroll
                for (int m = 0; m < 4; ++m) { const int s = (row0 + ai * HALF + m * 16) & 4095; cc[m] = (f32x4){1.f, 1.f, 1.f, 1.f}; ss[m] = (f32x4){0.f, 0.f, 0.f, 0.f};
                    if (rope_lane) { cc[m] = *(const f32x4*)(cs + s * 8 + 4 * fq); ss[m] = *(const f32x4*)(sn + s * 8 + 4 * fq); } }
                asm volatile("" ::: "memory");
#pragma unroll
                for (int m = 0; m < 4; ++m) { const int row = row0 + ai * HALF + m * 16; const float r = (pn < 2 ? QSCALE : 1.0f);
#pragma unroll
                    for (int bj = 0; bj < 2; ++bj) { const f32x4 v0 = acc[ai][bj][m][0] * r, v1 = acc[ai][bj][m][1] * r; const int tc = bj * HALF + cw;
                        bf16_t* dst = (pn < 2) ? AQ + (size_t)row * 512 + pn * 256 + tc : AKV + (size_t)row * 256 + tc;
                        if (rope_lane && !(pn == 2 && bj == 1)) {
                            const f32x4 r1 = v0 * cc[m] - v1 * ss[m], r2 = v1 * cc[m] + v0 * ss[m];
                            dst -= 8 * fq;
                            *(u32x2*)(dst + 4 * fq) = pack4(r1); *(u32x2*)(dst + 8 + 4 * fq) = pack4(r2);
                        } else *(u32x4*)dst = pack8(v0, v1); } }
                asm volatile("" ::: "memory"); }
        } else if (pn <= 14) {
            bf16_t* base = (pn <= 6) ? MQK + (pn - 3) * 256 : (pn <= 10) ? MV + (pn - 7) * 256 : MO + (pn - 11) * 256; const bool sg = pn > 10;
#pragma unroll
            for (int ai = 0; ai < 2; ++ai)
#pragma unroll
                for (int m = 0; m < 4; ++m) { const int row = row0 + ai * HALF + m * 16;
#pragma unroll
                    for (int bj = 0; bj < 2; ++bj) { f32x4 v0 = acc[ai][bj][m][0], v1 = acc[ai][bj][m][1];
                        if (sg) {
#pragma unroll
                            for (int j = 0; j < 4; ++j) { v0[j] = fsig2(v0[j]); v1[j] = fsig2(v1[j]); } }
                        *(u32x4*)(base + (size_t)row * 1024 + bj * HALF + cw) = pack8(v0, v1); } }
        } else if (wc == 0 && fq < 2) {
            const f32x4 b0 = *(const f32x4*)(bgate + 8 * fq), b1 = *(const f32x4*)(bgate + 8 * fq + 4);
#pragma unroll
            for (int ai = 0; ai < 2; ++ai)
#pragma unroll
                for (int m = 0; m < 4; ++m) { const int row = row0 + ai * HALF + m * 16;
                    const f32x4 li = acc[ai][0][m][0] + b0; f32x4 lf = acc[ai][0][m][1] + b1;
#pragma unroll
                    for (int j = 0; j < 4; ++j) lf[j] = fminf(lf[j], 0.f) - log1pf(expf(-fabsf(lf[j])));
                    *(f32x4*)(GATES + (size_t)row * 16 + 8 * fq) = li; *(f32x4*)(GATES + (size_t)row * 16 + 8 * fq + 4) = lf; }
        }
    }
};
struct EpiSig { static constexpr bool PERM = true, AFTER_DRAIN = false;
    bf16_t *BGA, *BGM;
    __device__ __forceinline__ void operator()(const f32x4 (&acc)[2][2][4][2], const Unit& u, int wr, int wc, int fr, int fq) const {
        const int row0 = u.pm * BM + wr * 64 + fr, cw = wc * 32 + 8 * fq; bf16_t* base = (u.pn < 4) ? BGA + u.pn * 256 : BGM + (u.pn - 4) * 256;
#pragma unroll
        for (int ai = 0; ai < 2; ++ai)
#pragma unroll
            for (int m = 0; m < 4; ++m) { const int row = row0 + ai * HALF + m * 16;
#pragma unroll
                for (int bj = 0; bj < 2; ++bj) { f32x4 v0 = acc[ai][bj][m][0], v1 = acc[ai][bj][m][1];
#pragma unroll
                    for (int j = 0; j < 4; ++j) { v0[j] = fsig2(v0[j]); v1[j] = fsig2(v1[j]); }
                    *(u32x4*)(base + (size_t)row * 1024 + bj * HALF + cw) = pack8(v0, v1); } }
    }
};
template <bool ADD> struct EpiMul { static constexpr bool PERM = true, AFTER_DRAIN = false;
    bf16_t* O; const bf16_t* G; const bf16_t* T;
    __device__ __forceinline__ void operator()(const f32x4 (&acc)[2][2][4][2], const Unit& u, int wr, int wc, int fr, int fq) const {
        const int row0 = u.pm * BM + wr * 64 + fr, col0 = u.pn * BM + wc * 32 + 8 * fq;
#pragma unroll
        for (int ai = 0; ai < 2; ++ai) {
            u32x4 gq[4][2], tq[4][2];
#pragma unroll
            for (int m = 0; m < 4; ++m)
#pragma unroll
                for (int bj = 0; bj < 2; ++bj) { const size_t ro = (size_t)(row0 + ai * HALF + m * 16) * 1024 + col0 + bj * HALF; gq[m][bj] = *(const u32x4*)(G + ro); if (ADD) tq[m][bj] = *(const u32x4*)(T + ro); }
            asm volatile("" ::: "memory");
#pragma unroll
            for (int m = 0; m < 4; ++m)
#pragma unroll
                for (int bj = 0; bj < 2; ++bj) { f32x4 g0, g1; unpack8(gq[m][bj], g0, g1); f32x4 v0 = acc[ai][bj][m][0] * g0, v1 = acc[ai][bj][m][1] * g1;
                    if (ADD) { f32x4 t0, t1; unpack8(tq[m][bj], t0, t1); v0 = v0 + t0; v1 = v1 + t1; }
                    gq[m][bj] = pack8(v0, v1); }
#pragma unroll
            for (int m = 0; m < 4; ++m)
#pragma unroll
                for (int bj = 0; bj < 2; ++bj) *(u32x4*)(O + (size_t)(row0 + ai * HALF + m * 16) * 1024 + col0 + bj * HALF) = gq[m][bj];
            asm volatile("" ::: "memory"); }
    }
};
struct EpiPlainNP { static constexpr bool PERM = true, AFTER_DRAIN = false;
    bf16_t* O;
    __device__ __forceinline__ void operator()(const f32x4 (&acc)[2][2][4][2], const Unit& u, int wr, int wc, int fr, int fq) const {
        const int row0 = u.pm * BM + wr * 64 + fr, col0 = u.pn * BM + wc * 32 + 8 * fq;
#pragma unroll
        for (int ai = 0; ai < 2; ++ai)
#pragma unroll
            for (int m = 0; m < 4; ++m) { const size_t ro = (size_t)(row0 + ai * HALF + m * 16) * 1024 + col0;
#pragma unroll
                for (int bj = 0; bj < 2; ++bj) *(u32x4*)(O + ro + bj * HALF) = pack8(acc[ai][bj][m][0], acc[ai][bj][m][1]); }
    }
};
struct PanelSsq {
    unsigned* xbuf;
    unsigned* cnt;
    unsigned* tmo; unsigned code;
    __device__ __forceinline__ static void partials(const f32x4 (&v)[2][2][4][2], int wr, int wc, int fr, int fq, PG8_LAS float* P) {
#pragma unroll
        for (int ai = 0; ai < 2; ++ai)
#pragma unroll
            for (int m = 0; m < 4; ++m) { float s = 0.f;
#pragma unroll
                for (int bj = 0; bj < 2; ++bj)
#pragma unroll
                    for (int n = 0; n < 2; ++n) { const f32x4 x = v[ai][bj][m][n]; s += (x[0] * x[0] + x[1] * x[1]) + (x[2] * x[2] + x[3] * x[3]); }
                s += __shfl_xor(s, 16); s += __shfl_xor(s, 32);
                if (fq == 0) P[(ai * HALF + wr * 64 + m * 16 + fr) * 4 + wc] = s; }
    }
    __device__ __forceinline__ bool run(const f32x4 (&v)[2][2][4][2], const Unit& u, int wr, int wc, int fr, int fq, PG8_LAS unsigned char* lds, int wid, int lane) const {
        PG8_LAS float* P = (PG8_LAS float*)lds;
        PG8_LAS float* S = (PG8_LAS float*)(lds + 8192);
        PG8_LAS unsigned* flag = (PG8_LAS unsigned*)(lds + 8192 + 2048);
        partials(v, wr, wc, fr, fq, P);
        if (wid == 0 && lane == 0) flag[0] = 0u;
        asm volatile("s_waitcnt lgkmcnt(0)" ::: "memory"); __builtin_amdgcn_s_barrier(); asm volatile("" ::: "memory");
        const int row = wid * 32 + (lane & 31);
        if (lane < 32) { const float t = (P[row * 4 + 0] + P[row * 4 + 1]) + (P[row * 4 + 2] + P[row * 4 + 3]);
            unsigned* slot = xbuf + (size_t)(u.pm * BM + row) * 4;
            __hip_atomic_store(slot + u.pn, __float_as_uint(t) | 1u, __ATOMIC_RELAXED, __HIP_MEMORY_SCOPE_AGENT);
            unsigned a0, a1, a2, a3; bool okk; int it = 0;
            do {
                a0 = __hip_atomic_load(slot + 0, __ATOMIC_RELAXED, __HIP_MEMORY_SCOPE_AGENT); a1 = __hip_atomic_load(slot + 1, __ATOMIC_RELAXED, __HIP_MEMORY_SCOPE_AGENT);
                a2 = __hip_atomic_load(slot + 2, __ATOMIC_RELAXED, __HIP_MEMORY_SCOPE_AGENT); a3 = __hip_atomic_load(slot + 3, __ATOMIC_RELAXED, __HIP_MEMORY_SCOPE_AGENT);
                okk = (a0 != 0u) & (a1 != 0u) & (a2 != 0u) & (a3 != 0u);
                if (__all(okk)) break;
                __builtin_amdgcn_s_sleep(1);
            } while (++it < 40000);
            const bool dead = !okk;
            if (dead) { __hip_atomic_store(tmo + 1, code | (unsigned)(u.pm & 0xff), __ATOMIC_RELAXED, __HIP_MEMORY_SCOPE_AGENT); __hip_atomic_store(tmo, 1u, __ATOMIC_RELAXED, __HIP_MEMORY_SCOPE_AGENT); flag[0] = 1u; }
            const float tt = (__uint_as_float(a0) + __uint_as_float(a1)) + (__uint_as_float(a2) + __uint_as_float(a3));
            S[row] = rsqrtf(tt * (1.f / 1024.f) + RMS_EPS); }
        asm volatile("s_waitcnt vmcnt(0) lgkmcnt(0)" ::: "memory"); __builtin_amdgcn_s_barrier(); asm volatile("" ::: "memory");
        const bool bad = flag[0] != 0u;
        return bad;
    }
};
struct EpiRmsRes { static constexpr bool PERM = true, AFTER_DRAIN = true;
    bf16_t* xn; const float* inv_prev; float* inv_new; const float* gpost; float scale; PanelSsq st, st2; unsigned poison;
    __device__ __forceinline__ void fused(f32x4 (&acc)[2][2][4][2], const Unit& u, int wr, int wc, int fr, int fq, PG8_LAS unsigned char* lds, int wid, int lane) const {
        const PG8_LAS float* S = (const PG8_LAS float*)(lds + 8192);
        const int col0 = u.pn * BM + wc * 32 + 8 * fq, row0 = u.pm * BM + wr * 64 + fr;
        const float sc_ = scale;
        u32x4 pre[4][2]; float iv[2][4];
#pragma unroll
        for (int m = 0; m < 4; ++m)
#pragma unroll
            for (int bj = 0; bj < 2; ++bj) pre[m][bj] = *(const u32x4*)(xn + (size_t)(row0 + m * 16) * 1024 + col0 + bj * HALF);
        const bool bad = st.run(acc, u, wr, wc, fr, fq, lds, wid, lane) || poison != 0u;
        int row1 = row0, col1 = col0; asm volatile("" : "+v"(row1), "+v"(col1));
#pragma unroll
        for (int ai = 0; ai < 2; ++ai)
#pragma unroll
            for (int m = 0; m < 4; ++m) iv[ai][m] = inv_prev[row1 + ai * HALF + m * 16];
        f32x4 gp[2][2];
#pragma unroll
        for (int bj = 0; bj < 2; ++bj)
#pragma unroll
            for (int n = 0; n < 2; ++n) { const f32x4 g4 = *(const f32x4*)(gpost + col1 + bj * HALF + 4 * n); gp[bj][n] = (f32x4){g4[0] * sc_, g4[1] * sc_, g4[2] * sc_, g4[3] * sc_}; }
#pragma unroll
        for (int ai = 0; ai < 2; ++ai) {
#pragma unroll
            for (int m = 0; m < 4; ++m) { const float sr = S[ai * HALF + wr * 64 + m * 16 + fr], ivr = iv[ai][m];
#pragma unroll
                for (int bj = 0; bj < 2; ++bj) { f32x4 b0, b1; unpack8(pre[m][bj], b0, b1);
                    acc[ai][bj][m][0] = b0 * ivr + acc[ai][bj][m][0] * sr * gp[bj][0]; acc[ai][bj][m][1] = b1 * ivr + acc[ai][bj][m][1] * sr * gp[bj][1]; } }
            if (ai == 0) {
#pragma unroll
                for (int m = 0; m < 4; ++m)
#pragma unroll
                    for (int bj = 0; bj < 2; ++bj) pre[m][bj] = *(const u32x4*)(xn + (size_t)(row1 + HALF + m * 16) * 1024 + col1 + bj * HALF);
            }
        }
        const bool bad2 = st2.run(acc, u, wr, wc, fr, fq, lds, wid, lane) || bad;
#pragma unroll
        for (int ai = 0; ai < 2; ++ai)
#pragma unroll
            for (int m = 0; m < 4; ++m) { const float sr = S[ai * HALF + wr * 64 + m * 16 + fr]; const size_t off = (size_t)(row1 + ai * HALF + m * 16) * 1024 + col1;
#pragma unroll
                for (int bj = 0; bj < 2; ++bj) { u32x4 w = pack8(acc[ai][bj][m][0] * sr, acc[ai][bj][m][1] * sr); if (bad2) w = (u32x4){0x7fc07fc0u, 0x7fc07fc0u, 0x7fc07fc0u, 0x7fc07fc0u}; *(u32x4*)(xn + off + bj * HALF) = w; } }
        if (u.pn == 0 && lane < 32) { const int row = wid * 32 + lane; inv_new[u.pm * BM + row] = 1.0f / S[row]; }
    }
};
struct EpiPle { static constexpr bool PERM = true, AFTER_DRAIN = true;
    const bf16_t* xn; const float* inv_prev; float* out; const bf16_t* PR; const float* gpost; PanelSsq st; unsigned poison;
    __device__ __forceinline__ void fused(f32x4 (&acc)[2][2][4][2], const Unit& u, int wr, int wc, int fr, int fq, PG8_LAS unsigned char* lds, int wid, int lane) const {
        const PG8_LAS float* S = (const PG8_LAS float*)(lds + 8192);
        const int col0 = u.pn * BM + wc * 32 + 8 * fq, row0 = u.pm * BM + wr * 64 + fr;
#pragma unroll
        for (int ai = 0; ai < 2; ++ai) {
            u32x4 prq[4][2];
#pragma unroll
            for (int m = 0; m < 4; ++m)
#pragma unroll
                for (int bj = 0; bj < 2; ++bj) prq[m][bj] = *(const u32x4*)(PR + (size_t)(row0 + ai * HALF + m * 16) * 1024 + col0 + bj * HALF);
            asm volatile("" ::: "memory");
#pragma unroll
            for (int m = 0; m < 4; ++m)
#pragma unroll
                for (int bj = 0; bj < 2; ++bj) { f32x4 p0, p1; unpack8(prq[m][bj], p0, p1); f32x4 a0 = acc[ai][bj][m][0], a1 = acc[ai][bj][m][1];
#pragma unroll
                    for (int j = 0; j < 4; ++j) { a0[j] = fsig2(a0[j]); a1[j] = fsig2(a1[j]); }
                    acc[ai][bj][m][0] = p0 * a0; acc[ai][bj][m][1] = p1 * a1; }
            asm volatile("" ::: "memory"); }
        const bool bad = st.run(acc, u, wr, wc, fr, fq, lds, wid, lane) || poison != 0u;
        asm volatile("" ::: "memory");
        const float qnan = __builtin_nanf("");
        f32x4 gp[2][2];
#pragma unroll
        for (int bj = 0; bj < 2; ++bj)
#pragma unroll
            for (int n = 0; n < 2; ++n) gp[bj][n] = *(const f32x4*)(gpost + col0 + bj * HALF + 4 * n);
#pragma unroll
        for (int ai = 0; ai < 2; ++ai)
#pragma unroll
            for (int mp = 0; mp < 2; ++mp) {
                u32x4 pre[2][2]; float iv[2];
#pragma unroll
                for (int mm = 0; mm < 2; ++mm) { const int m = 2 * mp + mm; iv[mm] = inv_prev[row0 + ai * HALF + m * 16];
#pragma unroll
                    for (int bj = 0; bj < 2; ++bj) pre[mm][bj] = *(const u32x4*)(xn + (size_t)(row0 + ai * HALF + m * 16) * 1024 + col0 + bj * HALF); }
                asm volatile("" ::: "memory");
#pragma unroll
                for (int mm = 0; mm < 2; ++mm) { const int m = 2 * mp + mm; const float sr = S[ai * HALF + wr * 64 + m * 16 + fr]; const size_t off = (size_t)(row0 + ai * HALF + m * 16) * 1024 + col0;
#pragma unroll
                    for (int bj = 0; bj < 2; ++bj) { f32x4 b0, b1; unpack8(pre[mm][bj], b0, b1);
                        f32x4 o0 = b0 * iv[mm] + acc[ai][bj][m][0] * sr * gp[bj][0], o1 = b1 * iv[mm] + acc[ai][bj][m][1] * sr * gp[bj][1];
                        if (bad) { o0 = (f32x4){qnan, qnan, qnan, qnan}; o1 = o0; }
                        *(f32x4*)(out + off + bj * HALF) = o0; *(f32x4*)(out + off + bj * HALF + 4) = o1; } }
                asm volatile("" ::: "memory"); }
    }
};
struct QueueOrder { StaticOrder so; unsigned* ctr; int limit; PG8_LAS int* slot; int wave, xlab;
    __device__ __forceinline__ bool next(int i, Unit& u) const {
        if (wave == 0) { int v = 0; int l_; asm volatile("v_mbcnt_lo_u32_b32 %0, -1, 0\n\tv_mbcnt_hi_u32_b32 %0, -1, %0" : "=v"(l_));
            if (l_ == 0) v = (int)__hip_atomic_fetch_add(ctr, 1u, __ATOMIC_RELAXED, __HIP_MEMORY_SCOPE_AGENT);
            v = __builtin_amdgcn_readfirstlane(v); if (l_ == 0) slot[i & 1] = v; }
        asm volatile("s_waitcnt vmcnt(0) lgkmcnt(0)" ::: "memory"); __builtin_amdgcn_s_barrier(); asm volatile("" ::: "memory");
        const int tk = __builtin_amdgcn_readfirstlane(slot[i & 1]);
        const int L = NXCD * tk + xlab;
        if (L >= limit) return false; StaticOrder t = so; t.G = 1; t.c = 0; return t.next(L, u); }
    __device__ __forceinline__ void a_ready(const Unit&) const {}
    __device__ __forceinline__ void done(const Unit&) const {}
};
struct RoundOrder { StaticOrder so; int round;
    __device__ __forceinline__ bool next(int i, Unit& u) const { return i == 0 && so.next(round, u); }
    __device__ __forceinline__ void a_ready(const Unit&) const {}
    __device__ __forceinline__ void done(const Unit&) const {}
};
__device__ __forceinline__ void zero4(f32x4& v) {
    typedef unsigned long long u64x2_ __attribute__((ext_vector_type(2)));
    unsigned long long lo, hi;
    asm volatile("v_mov_b64 %0, 0" : "=v"(lo)); asm volatile("v_mov_b64 %0, 0" : "=v"(hi));
    const u64x2_ z = {lo, hi}; v = __builtin_bit_cast(f32x4, z);
}
template <int KK, class Epi, class Sched, bool ALIGN_EPI = false, bool SP2 = false, bool ABLK = false>
__device__ __forceinline__ void gemm_phase(PG8_LAS unsigned char* lds, const Gemm g, const Sched& S, const Epi& E, const int wave_s) {
    int tid_; asm volatile("v_mbcnt_lo_u32_b32 %0, -1, 0\n\tv_mbcnt_hi_u32_b32 %0, -1, %0" : "=v"(tid_)); tid_ += wave_s * 64;
    const int tid = tid_, wid = wave_s, lane = tid & 63, wr = wid >> 2, wc = wid & 3, fr = lane & 15, fq = lane >> 4;
    constexpr int K = KK, nt = K / BK;
    unsigned voffA[2], voffB[2];
#pragma unroll
    for (int i = 0; i < 2; ++i) { int R, C; stage_rc(tid * 16 + i * 8192, R, C); const int Rb = Epi::PERM ? ((R & ~31) + perm32(R & 31)) : R;
        voffA[i] = ABLK ? (unsigned)(((R >> 1) * (K / 32) + (C >> 5)) * 128 + (R & 1) * 64 + (C & 31) * 2) : (unsigned)(R * K + C) * 2u; voffB[i] = (unsigned)(Rb * K + C) * 2u; }
    const size_t kstep = (size_t)(BK * 2);
    const size_t kstepA = ABLK ? (size_t)256 : kstep;
    const size_t hstep = (size_t)HALF * K * 2;
    const size_t tstep = 2 * hstep;
    const unsigned ldsw = (unsigned)wid * 1024u;
    const int aoff = lds_byte(wr * 64 + fr, fq * 8), boff = lds_byte(wc * 32 + fr, fq * 8);
#define PG8_SA(b, h) (((b) * 2 + (h)) * HTB)
#define PG8_SB(b, h) ((4 + (b) * 2 + (h)) * HTB)
#define PG8_STAGE(bufoff, gbase, voff) do { _Pragma("unroll") for (int _i = 0; _i < 2; ++_i) \
        __builtin_amdgcn_global_load_lds((const unsigned*)((const char*)(gbase) + (voff)[_i]), (PG8_LAS unsigned*)(lds + (bufoff) + ldsw + _i * 8192), 16, 0, 0); } while (0)
#define PG8_LDA(dst, b, h) do { _Pragma("unroll") for (int m = 0; m < 4; ++m) _Pragma("unroll") for (int k = 0; k < 2; ++k) dst[m][k] = *(const PG8_LAS bf16x8*)(lds + PG8_SA(b, h) + aoff + m * 2048 + k * 1024); } while (0)
#define PG8_LDB(dst, b, h) do { _Pragma("unroll") for (int n = 0; n < 2; ++n) _Pragma("unroll") for (int k = 0; k < 2; ++k) dst[n][k] = *(const PG8_LAS bf16x8*)(lds + PG8_SB(b, h) + boff + n * 2048 + k * 1024); } while (0)
#define PG8_MMA(ai, bj, At, Bt) do { __builtin_amdgcn_s_setprio(1); _Pragma("unroll") for (int m = 0; m < 4; ++m) _Pragma("unroll") for (int n = 0; n < 2; ++n) _Pragma("unroll") for (int k = 0; k < 2; ++k) \
        acc[ai][bj][m][n] = __builtin_amdgcn_mfma_f32_16x16x32_bf16(Bt[n][k], At[m][k], acc[ai][bj][m][n], 0, 0, 0); __builtin_amdgcn_s_setprio(0); } while (0)
#define PG8_WAIT_V(n) asm volatile("s_waitcnt vmcnt(" #n ")" ::: "memory")
#define PG8_WAIT_L(n) asm volatile("s_waitcnt lgkmcnt(" #n ")" ::: "memory")
#define PG8_BAR __builtin_amdgcn_s_barrier()
#define PG8_SCHED __builtin_amdgcn_sched_barrier(0)
    Unit cur, nxt; int ui = 0;
    if (!S.next(0, cur)) return;
    f32x4 acc[2][2][4][2];
#pragma unroll
    for (int a = 0; a < 2; ++a)
#pragma unroll
        for (int b = 0; b < 2; ++b)
#pragma unroll
            for (int m = 0; m < 4; ++m)
#pragma unroll
                for (int n = 0; n < 2; ++n) acc[a][b][m][n] = (f32x4){0.f, 0.f, 0.f, 0.f};
    bf16x8 At[4][2], B0[2][2], B1[2][2];
    const char* cA = (const char*)g.A + (size_t)cur.pm * tstep; const char* cB = (const char*)g.Bt + (size_t)cur.pn * tstep;
    S.a_ready(cur);
    if constexpr (SP2) {
        PG8_STAGE(PG8_SB(0, 0), cB, voffB); PG8_STAGE(PG8_SB(0, 1), cB + hstep, voffB); PG8_STAGE(PG8_SA(0, 0), cA, voffA); PG8_STAGE(PG8_SA(0, 1), cA + hstep, voffA);
        if (wr == 1) PG8_BAR;
        PG8_WAIT_V(2); PG8_BAR;
        PG8_STAGE(PG8_SB(1, 0), cB + kstep, voffB); PG8_STAGE(PG8_SA(1, 0), cA + kstepA, voffA); PG8_STAGE(PG8_SB(1, 1), cB + hstep + kstep, voffB);
        PG8_WAIT_V(6); PG8_BAR;
    } else {
        PG8_STAGE(PG8_SB(0, 0), cB, voffB); PG8_STAGE(PG8_SA(0, 0), cA, voffA); PG8_STAGE(PG8_SB(0, 1), cB + hstep, voffB); PG8_STAGE(PG8_SA(0, 1), cA + hstep, voffA);
        if (wr == 1) PG8_BAR;
        PG8_WAIT_V(4); PG8_BAR;
        PG8_STAGE(PG8_SB(1, 0), cB + kstep, voffB); PG8_STAGE(PG8_SA(1, 0), cA + kstepA, voffA); PG8_STAGE(PG8_SB(1, 1), cB + hstep + kstep, voffB);
        PG8_WAIT_V(6); PG8_BAR;
    }
    for (;;) {
        const bool has_next = S.next(ui + 1, nxt);
        const char* nA = has_next ? (const char*)g.A + (size_t)nxt.pm * tstep : cA; const char* nB = has_next ? (const char*)g.Bt + (size_t)nxt.pn * tstep : cB;
#pragma nounroll
        for (int t = 0; t < nt; t += 2) {
            const bool last = (t == nt - 2);
            const char* a1 = cA + (size_t)(t + 1) * kstepA;
            const char* a2 = last ? nA : cA + (size_t)(t + 2) * kstepA; const char* b2 = last ? nB : cB + (size_t)(t + 2) * kstep;
            const char* a3 = a2 + kstepA; const char* b3 = b2 + kstep;
            if (last && has_next) S.a_ready(nxt);
            if constexpr (SP2) {
            PG8_LDB(B0, 0, 0); PG8_LDB(B1, 0, 1); PG8_SCHED; PG8_LDA(At, 0, 0); PG8_STAGE(PG8_SA(1, 1), a1 + hstep, voffA);
            PG8_WAIT_V(8); PG8_WAIT_L(0); PG8_BAR; PG8_MMA(0, 0, At, B0); PG8_MMA(0, 1, At, B1); PG8_BAR; PG8_SCHED;
            PG8_LDA(At, 0, 1); PG8_STAGE(PG8_SB(0, 0), b2, voffB); PG8_STAGE(PG8_SB(0, 1), b2 + hstep, voffB); PG8_STAGE(PG8_SA(0, 0), a2, voffA);
            PG8_WAIT_V(8); PG8_WAIT_L(0); PG8_BAR; PG8_MMA(1, 0, At, B0); PG8_MMA(1, 1, At, B1); PG8_BAR; PG8_SCHED;
            PG8_LDB(B0, 1, 0); PG8_LDB(B1, 1, 1); PG8_SCHED; PG8_LDA(At, 1, 0); PG8_STAGE(PG8_SA(0, 1), a2 + hstep, voffA);
            PG8_WAIT_V(8); PG8_WAIT_L(0); PG8_BAR; PG8_MMA(0, 0, At, B0); PG8_MMA(0, 1, At, B1); PG8_BAR; PG8_SCHED;
            PG8_LDA(At, 1, 1); PG8_STAGE(PG8_SB(1, 0), b3, voffB); PG8_STAGE(PG8_SB(1, 1), b3 + hstep, voffB); PG8_STAGE(PG8_SA(1, 0), a3, voffA);
            PG8_WAIT_V(8); PG8_WAIT_L(0); PG8_BAR; PG8_MMA(1, 0, At, B0); PG8_MMA(1, 1, At, B1); PG8_BAR; PG8_SCHED;
            } else {
            PG8_LDB(B0, 0, 0); PG8_SCHED; PG8_LDA(At, 0, 0); PG8_STAGE(PG8_SA(1, 1), a1 + hstep, voffA);
            PG8_WAIT_L(8); PG8_BAR; PG8_WAIT_L(0); PG8_MMA(0, 0, At, B0); PG8_BAR; PG8_SCHED;
            PG8_LDB(B1, 0, 1); PG8_STAGE(PG8_SB(0, 0), b2, voffB);
            PG8_BAR; PG8_WAIT_L(0); PG8_MMA(0, 1, At, B1); PG8_BAR;
            PG8_LDA(At, 0, 1); PG8_STAGE(PG8_SA(0, 0), a2, voffA);
            PG8_BAR; PG8_WAIT_L(0); PG8_MMA(1, 0, At, B0); PG8_BAR; PG8_SCHED;
            PG8_STAGE(PG8_SB(0, 1), b2 + hstep, voffB);
            PG8_WAIT_V(6); PG8_BAR; PG8_MMA(1, 1, At, B1); PG8_BAR;
            PG8_LDB(B0, 1, 0); PG8_SCHED; PG8_LDA(At, 1, 0); PG8_STAGE(PG8_SA(0, 1), a2 + hstep, voffA);
            PG8_WAIT_L(8); PG8_BAR; PG8_WAIT_L(0); PG8_MMA(0, 0, At, B0); PG8_BAR; PG8_SCHED;
            PG8_LDB(B1, 1, 1); PG8_STAGE(PG8_SB(1, 0), b3, voffB);
            PG8_BAR; PG8_WAIT_L(0); PG8_MMA(0, 1, At, B1); PG8_BAR;
            PG8_LDA(At, 1, 1); PG8_STAGE(PG8_SA(1, 0), a3, voffA);
            PG8_BAR; PG8_WAIT_L(0); PG8_MMA(1, 0, At, B0); PG8_BAR; PG8_SCHED;
            PG8_STAGE(PG8_SB(1, 1), b3 + hstep, voffB);
            PG8_WAIT_V(6); PG8_BAR; PG8_MMA(1, 1, At, B1); PG8_BAR;
            }
        }
        if constexpr (ALIGN_EPI) { if (wr == 0) PG8_BAR; }
        if constexpr (!Epi::AFTER_DRAIN) { int fr_ = fr, fq_ = fq; asm volatile("" : "+v"(fr_), "+v"(fq_));
            E(acc, cur, wr, wc, fr_, fq_); S.done(cur); }
        if (!has_next) break;
#pragma unroll
        for (int a = 0; a < 2; ++a)
#pragma unroll
            for (int b = 0; b < 2; ++b)
#pragma unroll
                for (int m = 0; m < 4; ++m)
#pragma unroll
                    for (int n = 0; n < 2; ++n) zero4(acc[a][b][m][n]);
        cur = nxt; cA = nA; cB = nB; ++ui;
        if constexpr (ALIGN_EPI) { if (wr == 1) PG8_BAR; }
    }
    PG8_WAIT_V(0);
    if constexpr (!ALIGN_EPI) { if (wr == 0) PG8_BAR; }
    PG8_BAR;
    if constexpr (Epi::AFTER_DRAIN) { int fr_ = fr, fq_ = fq, lane_ = lane; asm volatile("" : "+v"(fr_), "+v"(fq_), "+v"(lane_)); E.fused(acc, cur, wr, wc, fr_, fq_, lds, wid, lane_); S.done(cur); }
#undef PG8_SA
#undef PG8_SB
#undef PG8_STAGE
#undef PG8_LDA
#undef PG8_LDB
#undef PG8_MMA
#undef PG8_WAIT_V
#undef PG8_WAIT_L
#undef PG8_BAR
#undef PG8_SCHED
}
}
constexpr int NWAVES = 8;
constexpr int BATCH = 8, SEQ = 4096, DM = 1024, PLE_DIM = 256, FFN = 2816, M = BATCH * SEQ;
constexpr int INW = 5904;
constexpr size_t MiB = 1u << 20;
constexpr size_t WS_CTL = 0, CTL_ZERO_BYTES = 1 * MiB;
constexpr size_t WS_W1A = 2 * MiB, WS_W2A = WS_W1A + 11 * MiB, WS_WINA = WS_W2A + 11 * MiB / 2, WS_WINB = WS_WINA + 8 * MiB, WS_WBA = WS_WINB + 4 * MiB, WS_WBM = WS_WBA + 1 * MiB,
                 WS_WOUT = WS_WBM + 2 * MiB, WS_W1B = WS_WOUT + 2 * MiB, WS_W2B = WS_W1B + 11 * MiB, WS_WPG = WS_W2B + 11 * MiB / 2, WS_WPP = WS_WPG + 2 * MiB, WS_WEND = WS_WPP + MiB / 2;
static_assert(WS_WEND <= 55 * MiB, "weights");
constexpr size_t WS_ROPE = 55 * MiB;
constexpr size_t WS_SSQ = 56 * MiB;
constexpr size_t WS_GATES = 58 * MiB;
constexpr size_t WS_XBUF = 60 * MiB;
constexpr size_t WS_XN = 64 * MiB;
constexpr size_t WS_AQ = 128 * MiB, WS_AKV = 160 * MiB, WS_MQK = 176 * MiB, WS_MV = 240 * MiB, WS_MO = 304 * MiB, WS_CQK = 368 * MiB, WS_HSF = 176 * MiB, WS_HSB = 432 * MiB, WS_HM = 304 * MiB;
constexpr size_t WS_BGA = 240 * MiB, WS_BGM = 176 * MiB, WS_T1 = 432 * MiB, WS_MG = 368 * MiB, WS_H = 128 * MiB, WS_PR = 304 * MiB, WS_PB = 496 * MiB, WS_END = 512 * MiB;
constexpr int CW_TMO = 0, CW_CODE = 1;
constexpr int CW_HMG = 2048;
constexpr int CW_G3BQ = 1024;
constexpr int CW_BAR = 4096;
constexpr int CW_SEAM = 32768, SEAM_BANK = 128 * 64;
static_assert((CW_SEAM + 7 * SEAM_BANK) * 4 <= (int)CTL_ZERO_BYTES, "CTL words inside the memset region");
constexpr int RING_OFF = 0, RING_BYTES = 131072;
constexpr int LDS_BYTES = 163840;
constexpr int LDSCTL_OFF = LDS_BYTES - 512, MISC_OFF = LDSCTL_OFF + 320;
#define GAS __attribute__((address_space(1)))
#define LAS __attribute__((address_space(3)))
typedef unsigned short bf16;
typedef unsigned v4u __attribute__((ext_vector_type(4)));
typedef float f32x4 __attribute__((ext_vector_type(4)));
typedef short bf16x8 __attribute__((ext_vector_type(8)));
typedef GAS unsigned gu32;
typedef GAS unsigned long long gu64;
#define RLX_AGENT __ATOMIC_RELAXED, __HIP_MEMORY_SCOPE_AGENT
#define LDS_WAIT() asm volatile("s_waitcnt lgkmcnt(0)" ::: "memory")
#define VM_WAIT() asm volatile("s_waitcnt vmcnt(0)" ::: "memory")
__device__ __forceinline__ unsigned long long rt() { return __builtin_amdgcn_s_memrealtime(); }
__device__ __forceinline__ unsigned f2bf(float f) { unsigned u = __builtin_bit_cast(unsigned, f); return (u + 0x7fffu + ((u >> 16) & 1u)) >> 16; }
__device__ __forceinline__ unsigned pk2(float lo, float hi) { return pg8::cvt_pk_bf16(lo, hi); }

#define XB_TMO      128
#define XB_XCNT(j)  (256  + 64 * (j))
#define XB_XSUB(j)  (1280 + 64 * (j))
#define XB_XGEN(j)  (2304 + 64 * (j))
#define XB_TOP      3328
#define XB_TOPGEN   3392
#define XCD_BAR_WORDS 3456
#define XB_SPIN_CAP (1u << 18)

__device__ __forceinline__ unsigned xb_ld(unsigned* p)              { return __hip_atomic_load(p, __ATOMIC_RELAXED, __HIP_MEMORY_SCOPE_AGENT); }
__device__ __forceinline__ unsigned xb_add(unsigned* p, unsigned v) { return __hip_atomic_fetch_add(p, v, __ATOMIC_RELAXED, __HIP_MEMORY_SCOPE_AGENT); }
__device__ __forceinline__ unsigned xb_xcc_id() { return (unsigned)__builtin_amdgcn_s_getreg((3 << 11) | 20) & 0xFu; }
#define XB_SPIN(cond, bar) do { unsigned _sp = 0; while (cond) { __builtin_amdgcn_s_sleep(1); \
    if ((++_sp & 255u) == 0u) { if (xb_ld(&(bar)[XB_TMO])) break; if (_sp > XB_SPIN_CAP) { atomicAdd(&(bar)[XB_TMO], 1u); break; } } } } while (0)

__device__ __forceinline__ int lane_id() { int l; asm volatile("v_mbcnt_lo_u32_b32 %0, -1, 0\n\tv_mbcnt_hi_u32_b32 %0, -1, %0" : "=v"(l)); return l; }
struct XcdBarrier {
    int wave; unsigned* bar; unsigned x;
    volatile LAS unsigned* st;
};

__device__ __forceinline__ XcdBarrier xcd_barrier_post(unsigned* bar, volatile LAS unsigned* st, int wave) {
    XcdBarrier b; b.bar = bar; b.x = xb_xcc_id(); b.st = st; b.wave = wave;
    if (wave == 0 && lane_id() == 0) (void)xb_add(&bar[XB_XCNT(b.x)], 1u);
    return b;
}
__device__ __forceinline__ void xcd_barrier_complete(unsigned* bar, unsigned x, unsigned& nloc, unsigned& nx) {
    const unsigned G = gridDim.x * gridDim.y * gridDim.z;
    unsigned sum, cnt, mine, sp = 0u;
    for (;;) {
        sum = 0u; cnt = 0u;
#pragma nounroll
        for (unsigned j = 0; j < 16; ++j) { const unsigned c = xb_ld(&bar[XB_XCNT(j)]); sum += c; cnt += (c > 0u) ? 1u : 0u; }
        if (sum == G) break;
        __builtin_amdgcn_s_sleep(1);
        if ((++sp & 255u) == 0u) { if (xb_ld(&bar[XB_TMO])) break; if (sp > XB_SPIN_CAP) { atomicAdd(&bar[XB_TMO], 1u); break; } }
    }
    mine = xb_ld(&bar[XB_XCNT(x)]);
    nloc = mine > 0u ? mine : 1u; nx = cnt > 0u ? cnt : 1u;
}

__device__ __forceinline__ void xcd_barrier(const XcdBarrier& b) {
    asm volatile("s_waitcnt vmcnt(0)" ::: "memory");
    __syncthreads();
    if (b.wave == 0 && lane_id() == 0) {
        unsigned* bar = b.bar;
        __builtin_amdgcn_s_waitcnt(0);
        unsigned nloc = b.st[0], nx = b.st[1];
        if (nloc == 0u) { xcd_barrier_complete(bar, b.x, nloc, nx); b.st[0] = nloc; b.st[1] = nx; }
        const unsigned old = xb_add(&bar[XB_XSUB(b.x)], 1u);
        const unsigned gen = old / nloc;
        if (old + 1u == (gen + 1u) * nloc) {
            __builtin_amdgcn_fence(__ATOMIC_RELEASE, "agent");
            asm volatile("s_waitcnt vmcnt(0)" ::: "memory");
            const unsigned og = xb_add(&bar[XB_TOP], 1u);
            const unsigned tg = og / nx;
            if (og + 1u == (tg + 1u) * nx) xb_add(&bar[XB_TOPGEN], 1u);
            else XB_SPIN(xb_ld(&bar[XB_TOPGEN]) == tg, bar);
            __builtin_amdgcn_fence(__ATOMIC_ACQUIRE, "agent");
            xb_add(&bar[XB_XGEN(b.x)], 1u);
            asm volatile("s_waitcnt vmcnt(0)" ::: "memory");
        } else {
            XB_SPIN(xb_ld(&bar[XB_XGEN(b.x)]) == gen, bar);
            __builtin_amdgcn_fence(__ATOMIC_ACQUIRE, "agent");
            asm volatile("s_waitcnt vmcnt(0)" ::: "memory");
        }
    }
    __syncthreads();
}
namespace mix {
typedef short bf16x8 __attribute__((ext_vector_type(8)));
typedef short s16x4 __attribute__((ext_vector_type(4)));
typedef float f32x4 __attribute__((ext_vector_type(4)));
typedef float f32x16 __attribute__((ext_vector_type(16)));
typedef unsigned u32x4 __attribute__((ext_vector_type(4)));
typedef unsigned u32x2 __attribute__((ext_vector_type(2)));
constexpr float LOG2E = 1.4426950408889634f;
__device__ __forceinline__ unsigned cvt2(float lo, float hi) { return pg8::cvt_pk_bf16(lo, hi); }
__device__ __forceinline__ float bflo(unsigned w) { return __uint_as_float(w << 16); }
__device__ __forceinline__ float bfhi(unsigned w) { return __uint_as_float(w & 0xffff0000u); }
__device__ __forceinline__ s16x4 tr16(LAS unsigned char* p) { typedef short v4i16_t __attribute__((ext_vector_type(4))); return __builtin_bit_cast(s16x4, __builtin_amdgcn_ds_read_tr16_b64_v4i16((LAS v4i16_t*)p)); }
__device__ __forceinline__ bf16x8 cat8(s16x4 a, s16x4 b) { return (bf16x8){a[0], a[1], a[2], a[3], b[0], b[1], b[2], b[3]}; }
__device__ __forceinline__ bf16x8 u4_to_b8(u32x4 w) { return __builtin_bit_cast(bf16x8, w); }

constexpr int AT_KROW = 144, AT_KEYS = 320, AT_LDS_K = 0, AT_LDS_V = AT_KEYS * AT_KROW;
__device__ __forceinline__ void attn_item(int item, LAS unsigned char* lds, const bf16* AQ, const bf16* AKV, bf16* ATT, const float* sink, int tid_in) {
    int tid = tid_in; asm volatile("" : "+v"(tid));
    const int lane = tid & 63, wid = __builtin_amdgcn_readfirstlane(tid >> 6), r32 = lane & 31, hi = lane >> 5;
    const int qb = item & 63, kvh = (item >> 6) & 1, b = item >> 7;
    const int q0 = qb * 64;
    const size_t rowbase = (size_t)b * SEQ;
#pragma unroll
    for (int i = 0; i < 5; ++i) { const int id = tid + 512 * i, key = id >> 3, c = id & 7; const int pos = q0 - 128 + key;
        if (pos >= 0 && pos < SEQ) { const bf16* src = AKV + (rowbase + pos) * 256 + kvh * 64 + c * 8;
            const u32x4 kk = *(const u32x4*)src, vv = *(const u32x4*)(src + 128);
            *(LAS u32x4*)(lds + AT_LDS_K + key * AT_KROW + c * 16) = kk;
            *(LAS u32x4*)(lds + AT_LDS_V + key * 128 + (((c >> 2) ^ ((key >> 1) & 1)) << 6) + (c & 3) * 16) = vv; } }
    const int g4 = wid & 3, rh = wid >> 2, hq = kvh * 4 + g4;
    const int qrow0 = q0 + 32 * rh;
    bf16x8 qf[4];
    { const bf16* qp = AQ + (rowbase + qrow0 + r32) * 512 + hq * 64 + hi * 8;
#pragma unroll
      for (int ks = 0; ks < 4; ++ks) qf[ks] = u4_to_b8(*(const u32x4*)(qp + ks * 16)); }
    const float sk = sink[hq] * LOG2E;
    float mrun = sk, lsum = (hi == 0) ? 1.0f : 0.0f;
    f32x16 o0 = {}, o1 = {};
    asm volatile("s_waitcnt vmcnt(0) lgkmcnt(0)" ::: "memory"); __builtin_amdgcn_s_barrier(); asm volatile("" ::: "memory");
#pragma nounroll
    for (int t = 0; t < 9; ++t) {
        const int kpos0 = qrow0 - 128 + 32 * t;
        if (kpos0 < 0 || kpos0 >= SEQ) continue;
        const int kl0 = 32 * rh + 32 * t;
        f32x16 s = {};
        { LAS unsigned char* kp = lds + AT_LDS_K + (kl0 + r32) * AT_KROW + hi * 16;
#pragma unroll
          for (int ks = 0; ks < 4; ++ks) { const bf16x8 kf = *(LAS bf16x8*)(kp + ks * 32); s = __builtin_amdgcn_mfma_f32_32x32x16_bf16(kf, qf[ks], s, 0, 0, 0); } }
        if (t == 0) {
#pragma unroll
            for (int i = 0; i < 16; ++i) { const int c = (i & 3) + 8 * (i >> 2) + 4 * hi; if (c < r32) s[i] = -INFINITY; }
        } else if (t == 8) {
#pragma unroll
            for (int i = 0; i < 16; ++i) { const int c = (i & 3) + 8 * (i >> 2) + 4 * hi; if (c > r32) s[i] = -INFINITY; }
        }
        float tm = s[0];
#pragma unroll
        for (int i = 1; i < 16; ++i) tm = fmaxf(tm, s[i]);
        tm = fmaxf(tm, __shfl_xor(tm, 32));
        if (__any(tm > mrun)) {
            const float mnew = fmaxf(mrun, tm), alpha = __builtin_amdgcn_exp2f(mrun - mnew);
            mrun = mnew; lsum *= alpha;
#pragma unroll
            for (int i = 0; i < 16; ++i) { o0[i] *= alpha; o1[i] *= alpha; }
        }
        float ps = 0.f;
#pragma unroll
        for (int i = 0; i < 16; ++i) { s[i] = __builtin_amdgcn_exp2f(s[i] - mrun); ps += s[i]; }
        lsum += ps;
        bf16x8 pf[2];
#pragma unroll
        for (int ks = 0; ks < 2; ++ks) { u32x4 w; w.x = cvt2(s[8 * ks + 0], s[8 * ks + 1]); w.y = cvt2(s[8 * ks + 2], s[8 * ks + 3]); w.z = cvt2(s[8 * ks + 4], s[8 * ks + 5]); w.w = cvt2(s[8 * ks + 6], s[8 * ks + 7]); pf[ks] = u4_to_b8(w); }
        { const int li = lane & 15, q = li >> 2, p = li & 3, dsel = (lane >> 4) & 1;
#pragma unroll
          for (int ks = 0; ks < 2; ++ks) {
#pragma unroll
            for (int dt = 0; dt < 2; ++dt) {
                const int key_a = kl0 + 16 * ks + 4 * hi + q, key_b = key_a + 8;
                LAS unsigned char* pa = lds + AT_LDS_V + key_a * 128 + ((dt ^ ((key_a >> 1) & 1)) << 6) + dsel * 32 + p * 8;
                LAS unsigned char* pb = lds + AT_LDS_V + key_b * 128 + ((dt ^ ((key_b >> 1) & 1)) << 6) + dsel * 32 + p * 8;
                const bf16x8 vf = cat8(tr16(pa), tr16(pb));
                if (dt == 0) o0 = __builtin_amdgcn_mfma_f32_32x32x16_bf16(vf, pf[ks], o0, 0, 0, 0);
                else         o1 = __builtin_amdgcn_mfma_f32_32x32x16_bf16(vf, pf[ks], o1, 0, 0, 0); } } }
    }
    lsum += __shfl_xor(lsum, 32);
    const float il = 1.0f / lsum;
    bf16* op = ATT + (rowbase + qrow0 + r32) * 512 + hq * 64 + 4 * hi;
#pragma unroll
    for (int gq = 0; gq < 4; ++gq) {
        u32x2 w0, w1; w0.x = cvt2(o0[4 * gq] * il, o0[4 * gq + 1] * il); w0.y = cvt2(o0[4 * gq + 2] * il, o0[4 * gq + 3] * il);
        w1.x = cvt2(o1[4 * gq] * il, o1[4 * gq + 1] * il); w1.y = cvt2(o1[4 * gq + 2] * il, o1[4 * gq + 3] * il);
        *(u32x2*)(op + 8 * gq) = w0; *(u32x2*)(op + 32 + 8 * gq) = w1; }
    asm volatile("s_waitcnt lgkmcnt(0)" ::: "memory"); __builtin_amdgcn_s_barrier(); asm volatile("" ::: "memory");
}

__device__ __forceinline__ void attn_run(int item0, int istep, int nitems, LAS unsigned char* lds, const bf16* AQ, const bf16* AKV, bf16* ATT, const float* sink, int tid_in) {
    int tid = tid_in; asm volatile("" : "+v"(tid));
    const int lane = tid & 63, wid = __builtin_amdgcn_readfirstlane(tid >> 6), r32 = lane & 31, hi = lane >> 5;
    u32x4 pk[5], pv[5];
#define AT_LOADKV(it_) do { const int qb_ = (it_) & 63, kvh_ = ((it_) >> 6) & 1, b_ = (it_) >> 7; \
        _Pragma("unroll") for (int i = 0; i < 5; ++i) { const int id = tid + 512 * i, key = id >> 3, c = id & 7; const int pos = qb_ * 64 - 128 + key; \
            if (pos >= 0 && pos < SEQ) { const bf16* src = AKV + ((size_t)b_ * SEQ + pos) * 256 + kvh_ * 64 + c * 8; pk[i] = *(const u32x4*)src; pv[i] = *(const u32x4*)(src + 128); } } } while (0)
    if (item0 < nitems) AT_LOADKV(item0);
#pragma nounroll
    for (int item = item0; item < nitems; item += istep) {
    const int qb = item & 63, kvh = (item >> 6) & 1, b = item >> 7;
    const int q0 = qb * 64;
    const size_t rowbase = (size_t)b * SEQ;
#pragma unroll
    for (int i = 0; i < 5; ++i) { const int id = tid + 512 * i, key = id >> 3, c = id & 7; const int pos = q0 - 128 + key;
        if (pos >= 0 && pos < SEQ) {
            *(LAS u32x4*)(lds + AT_LDS_K + key * AT_KROW + c * 16) = pk[i];
            *(LAS u32x4*)(lds + AT_LDS_V + key * 128 + (((c >> 2) ^ ((key >> 1) & 1)) << 6) + (c & 3) * 16) = pv[i]; } }
    const int g4 = wid & 3, rh = wid >> 2, hq = kvh * 4 + g4;
    const int qrow0 = q0 + 32 * rh;
    bf16x8 qf[4];
    { const bf16* qp = AQ + (rowbase + qrow0 + r32) * 512 + hq * 64 + hi * 8;
#pragma unroll
      for (int ks = 0; ks < 4; ++ks) qf[ks] = u4_to_b8(*(const u32x4*)(qp + ks * 16)); }
    if (item + istep < nitems) AT_LOADKV(item + istep);
    const float sk = sink[hq] * LOG2E;
    float mrun = sk, lsum = (hi == 0) ? 1.0f : 0.0f;
    f32x16 o0 = {}, o1 = {};
    asm volatile("s_waitcnt lgkmcnt(0)" ::: "memory"); __builtin_amdgcn_s_barrier(); asm volatile("" ::: "memory");
#pragma nounroll
    for (int t = 0; t < 9; ++t) {
        const int kpos0 = qrow0 - 128 + 32 * t;
        if (kpos0 < 0 || kpos0 >= SEQ) continue;
        const int kl0 = 32 * rh + 32 * t;
        f32x16 s = {};
        { LAS unsigned char* kp = lds + AT_LDS_K + (kl0 + r32) * AT_KROW + hi * 16;
#pragma unroll
          for (int ks = 0; ks < 4; ++ks) { const bf16x8 kf = *(LAS bf16x8*)(kp + ks * 32); s = __builtin_amdgcn_mfma_f32_32x32x16_bf16(kf, qf[ks], s, 0, 0, 0); } }
        if (t == 0) {
#pragma unroll
            for (int i = 0; i < 16; ++i) { const int c = (i & 3) + 8 * (i >> 2) + 4 * hi; if (c < r32) s[i] = -INFINITY; }
        } else if (t == 8) {
#pragma unroll
            for (int i = 0; i < 16; ++i) { const int c = (i & 3) + 8 * (i >> 2) + 4 * hi; if (c > r32) s[i] = -INFINITY; }
        }
        float tm = s[0];
#pragma unroll
        for (int i = 1; i < 16; ++i) tm = fmaxf(tm, s[i]);
        tm = fmaxf(tm, __shfl_xor(tm, 32));
        if (__any(tm > mrun)) {
            const float mnew = fmaxf(mrun, tm), alpha = __builtin_amdgcn_exp2f(mrun - mnew);
            mrun = mnew; lsum *= alpha;
#pragma unroll
            for (int i = 0; i < 16; ++i) { o0[i] *= alpha; o1[i] *= alpha; }
        }
        float ps = 0.f;
#pragma unroll
        for (int i = 0; i < 16; ++i) { s[i] = __builtin_amdgcn_exp2f(s[i] - mrun); ps += s[i]; }
        lsum += ps;
        bf16x8 pf[2];
#pragma unroll
        for (int ks = 0; ks < 2; ++ks) { u32x4 w; w.x = cvt2(s[8 * ks + 0], s[8 * ks + 1]); w.y = cvt2(s[8 * ks + 2], s[8 * ks + 3]); w.z = cvt2(s[8 * ks + 4], s[8 * ks + 5]); w.w = cvt2(s[8 * ks + 6], s[8 * ks + 7]); pf[ks] = u4_to_b8(w); }
        { const int li = lane & 15, q = li >> 2, p = li & 3, dsel = (lane >> 4) & 1;
#pragma unroll
          for (int ks = 0; ks < 2; ++ks) {
#pragma unroll
            for (int dt = 0; dt < 2; ++dt) {
                const int key_a = kl0 + 16 * ks + 4 * hi + q, key_b = key_a + 8;
                LAS unsigned char* pa = lds + AT_LDS_V + key_a * 128 + ((dt ^ ((key_a >> 1) & 1)) << 6) + dsel * 32 + p * 8;
                LAS unsigned char* pb = lds + AT_LDS_V + key_b * 128 + ((dt ^ ((key_b >> 1) & 1)) << 6) + dsel * 32 + p * 8;
                const bf16x8 vf = cat8(tr16(pa), tr16(pb));
                if (dt == 0) o0 = __builtin_amdgcn_mfma_f32_32x32x16_bf16(vf, pf[ks], o0, 0, 0, 0);
                else         o1 = __builtin_amdgcn_mfma_f32_32x32x16_bf16(vf, pf[ks], o1, 0, 0, 0); } } }
    }
    lsum += __shfl_xor(lsum, 32);
    const float il = 1.0f / lsum;
    bf16* op = ATT + (rowbase + qrow0 + r32) * 512 + hq * 64 + 8 * hi;
#pragma unroll
    for (int gp = 0; gp < 2; ++gp) {
#pragma unroll
        for (int hf = 0; hf < 2; ++hf) {
            unsigned ax, ay, bx_, by_;
            if (hf == 0) { ax = cvt2(o0[8 * gp] * il, o0[8 * gp + 1] * il); ay = cvt2(o0[8 * gp + 2] * il, o0[8 * gp + 3] * il); bx_ = cvt2(o0[8 * gp + 4] * il, o0[8 * gp + 5] * il); by_ = cvt2(o0[8 * gp + 6] * il, o0[8 * gp + 7] * il); }
            else         { ax = cvt2(o1[8 * gp] * il, o1[8 * gp + 1] * il); ay = cvt2(o1[8 * gp + 2] * il, o1[8 * gp + 3] * il); bx_ = cvt2(o1[8 * gp + 4] * il, o1[8 * gp + 5] * il); by_ = cvt2(o1[8 * gp + 6] * il, o1[8 * gp + 7] * il); }
            { auto r = __builtin_amdgcn_permlane32_swap(ax, bx_, false, false); ax = r[0]; bx_ = r[1]; }
            { auto r = __builtin_amdgcn_permlane32_swap(ay, by_, false, false); ay = r[0]; by_ = r[1]; }
            u32x4 w; w.x = ax; w.y = ay; w.z = bx_; w.w = by_;
            *(u32x4*)(op + 32 * hf + 16 * gp) = w; } }
    asm volatile("s_waitcnt lgkmcnt(0)" ::: "memory"); __builtin_amdgcn_s_barrier(); asm volatile("" ::: "memory");
    }
#undef AT_LOADKV
}

constexpr int ML_BUF = 49152, ML_Q = 0, ML_K = 16384, ML_V = 32768, ML_SC = 98304, ML_ARR = 106496, ML_ARRP = 2560;
constexpr int MA_A = 0, MA_M = 256, MA_WI = 512, MA_EN = 768, MA_WK = 1024, MA_SCAL = 1280;
constexpr int MB_DEN = 2 * ML_ARRP, MB_QN = MB_DEN + 512, MB_NV = MB_QN + 256;
__device__ __forceinline__ int swc(int row) { return (row & 3) | (((row >> 3) & 1) << 2); }
__device__ __forceinline__ int ml_off(int row, int dim) { return row * 256 + (((dim >> 4) ^ swc(row)) << 5) + (dim & 15) * 2; }
__device__ __forceinline__ int sc_off(int j, int t) { return j * 128 + ((((t >> 3)) ^ ((j >> 1) & 7)) << 4) + (t & 7) * 2; }
__device__ __forceinline__ float dppf(float old, float src, const int ctrl_sel) {
    const int o = __float_as_int(old), v = __float_as_int(src); int r;
    switch (ctrl_sel) {
        case 1: r = __builtin_amdgcn_update_dpp(o, v, 0x111, 0xf, 0xf, false); break;
        case 2: r = __builtin_amdgcn_update_dpp(o, v, 0x112, 0xf, 0xf, false); break;
        case 4: r = __builtin_amdgcn_update_dpp(o, v, 0x114, 0xf, 0xf, false); break;
        case 8: r = __builtin_amdgcn_update_dpp(o, v, 0x118, 0xf, 0xf, false); break;
        case 15: r = __builtin_amdgcn_update_dpp(o, v, 0x142, 0xa, 0xf, false); break;
        default: r = __builtin_amdgcn_update_dpp(o, v, 0x143, 0xc, 0xf, false); break;
    }
    return __int_as_float(r);
}
__device__ __forceinline__ float wave_scan_add(float x) { x += dppf(0.f, x, 1); x += dppf(0.f, x, 2); x += dppf(0.f, x, 4); x += dppf(0.f, x, 8); x += dppf(0.f, x, 15); x += dppf(0.f, x, 31); return x; }
__device__ __forceinline__ float wave_scan_max(float x) { const float ni = -INFINITY; x = fmaxf(x, dppf(ni, x, 1)); x = fmaxf(x, dppf(ni, x, 2)); x = fmaxf(x, dppf(ni, x, 4)); x = fmaxf(x, dppf(ni, x, 8)); x = fmaxf(x, dppf(ni, x, 15)); x = fmaxf(x, dppf(ni, x, 31)); return x; }
constexpr int M3_Q = 0, M3_K = 49152, M3_V = 98304, M3_SC = 131072, M3_ARR = 147456, M3_ARRS = 1536, M3_DEN = 152064, M3_QN = 152576, M3_NV = 152832, M3_FLAG = 153344, M3_END = 153600;
template <int MODE = 0>
__device__ __forceinline__ void mlstm_item3(int item, LAS unsigned char* lds, const bf16* CQK, const bf16* MV, const float* GATES, bf16* HSF, bf16* HSB, int tid_in) {
    int tid = tid_in; asm volatile("" : "+v"(tid));
    const int lane = tid & 63, wid = __builtin_amdgcn_readfirstlane(tid >> 6), l15 = lane & 15, g = lane >> 4;
    const int dvh = item & 1, dir = (item >> 1) & 1, h = (item >> 2) & 3, b = item >> 4;
    bf16* HS = dir ? HSB : HSF;
    const size_t rowbase = (size_t)b * SEQ;
    LAS float* aDEN = (LAS float*)(lds + M3_DEN); LAS float* aQN = (LAS float*)(lds + M3_QN); LAS float* aNV = (LAS float*)(lds + M3_NV); LAS unsigned* aFLAG = (LAS unsigned*)(lds + M3_FLAG);
#define M3_GROW(c, row) (rowbase + (size_t)(dir ? (SEQ - 1 - (64 * (c) + (row))) : (64 * (c) + (row))))
#define M3_BAR() do { asm volatile("s_waitcnt lgkmcnt(0)" ::: "memory"); __builtin_amdgcn_s_barrier(); asm volatile("" ::: "memory"); } while (0)
    if (tid < 128) aNV[tid] = 0.f;
    __builtin_amdgcn_s_waitcnt(0);
    if (tid < 4) aFLAG[tid] = 0u;
    if (wid >= 4) {
        const int tt_ = tid - 256;
        u32x4 pqA[4], pkA[4], pvA[4], pqB[4], pkB[4], pvB[4]; float gliA = 0.f, glfA = 0.f, gliB = 0.f, glfB = 0.f, m_prev = 0.f;
        int wo_, tq_[4], tw_[4];
        unsigned lo_ = (unsigned)(((dir ? 63 - (tt_ >> 4) : (tt_ >> 4)) * 1024 + (tt_ & 15) * 8) * 2), go_ = (unsigned)((dir ? 63 - lane : lane) * 64);
        asm volatile("" : "+v"(lo_), "+v"(go_));
        { const int swl = swc(l15), s2 = (l15 >> 1) & 7;
          wo_ = ml_off(tt_ >> 4, (tt_ & 15) * 8);
#pragma unroll
          for (int ks = 0; ks < 4; ++ks) tq_[ks] = l15 * 256 + (((2 * ks + (g >> 1)) ^ swl) << 5) + (g & 1) * 16;
#pragma unroll
          for (int tt = 0; tt < 4; ++tt) tw_[tt] = l15 * 128 + (((2 * tt + (g >> 1)) ^ s2) << 4) + (g & 1) * 8;
          asm volatile("" : "+v"(wo_));
#pragma unroll
          for (int k = 0; k < 4; ++k) asm volatile("" : "+v"(tq_[k]), "+v"(tw_[k])); }
#define M3_CBASE(c) ((size_t)(rowbase + (size_t)(dir ? SEQ - 64 * ((c) + 1) : 64 * (c))))
#define M3_LOAD_QK(c, S) do { const char* qb_ = (const char*)(CQK + M3_CBASE(c) * 1024 + h * 128); _Pragma("unroll") for (int i = 0; i < 4; ++i) { const char* p_ = qb_ + (dir ? -32768 * i : 32768 * i); \
            pq##S[i] = *(const u32x4*)(p_ + lo_); pk##S[i] = *(const u32x4*)(p_ + 1024 + lo_); } } while (0)
#define M3_LOAD_V(c, S) do { const char* vb_ = (const char*)(MV + M3_CBASE(c) * 1024 + h * 256 + dvh * 128); _Pragma("unroll") for (int i = 0; i < 4; ++i) { \
            pv##S[i] = *(const u32x4*)(vb_ + (dir ? -32768 * i : 32768 * i) + lo_); } } while (0)
#define M3_LOAD_G(c, S) do { const char* gb_ = (const char*)(GATES + M3_CBASE(c) * 16 + dir * 8 + h); gli##S = *(const float*)(gb_ + go_); glf##S = *(const float*)(gb_ + 16 + go_); } while (0)
#define M3_WRITE_QK(c, S) do { const int qo_ = ((c) % 3) * 16384; _Pragma("unroll") for (int i = 0; i < 4; ++i) { const int off = qo_ + wo_ + 4096 * i; \
            *(LAS u32x4*)(lds + M3_Q + off) = pq##S[i]; *(LAS u32x4*)(lds + M3_K + off) = pk##S[i]; } } while (0)
#define M3_WRITE_V(c, S) do { const int vo_ = ((c) & 1) * 16384; _Pragma("unroll") for (int i = 0; i < 4; ++i) { \
            *(LAS u32x4*)(lds + M3_V + vo_ + wo_ + 4096 * i) = pv##S[i]; } } while (0)
#define M3_GATES(c, S) do { if (wid == 7) { LAS float* A_ = (LAS float*)(lds + M3_ARR + ((c) % 3) * M3_ARRS); \
            const float bsum = wave_scan_add(glf##S); const float a = gli##S - bsum; const float pm = wave_scan_max(a); const float Mj = fmaxf(m_prev, pm); \
            const float M63 = __shfl(Mj, 63), b63 = __shfl(bsum, 63); \
            A_[MA_A / 4 + lane] = a * LOG2E; A_[MA_M / 4 + lane] = Mj * LOG2E; A_[MA_WI / 4 + lane] = __builtin_amdgcn_exp2f((m_prev - Mj) * LOG2E); A_[MA_EN / 4 + lane] = __builtin_amdgcn_exp2f(-(bsum + Mj) * LOG2E); \
            A_[MA_WK / 4 + lane] = __builtin_amdgcn_exp2f((a - M63) * LOG2E); if (lane == 0) A_[MA_SCAL / 4] = __builtin_amdgcn_exp2f((m_prev - M63) * LOG2E); \
            m_prev = b63 + M63; } } while (0)
#define M3_SCORE_ROWS(c, jt) do { const int qo_ = ((c) % 3) * 16384; LAS float* A_ = (LAS float*)(lds + M3_ARR + ((c) % 3) * M3_ARRS); const int j = 16 * (jt) + l15; \
            bf16x8 qb_[4]; _Pragma("unroll") for (int ks = 0; ks < 4; ++ks) qb_[ks] = *(LAS bf16x8*)(lds + M3_Q + qo_ + tq_[ks] + 4096 * (jt)); \
            const float Mj = A_[MA_M / 4 + j]; float rs = 0.f; \
            _Pragma("unroll") for (int tt = 0; tt < 4; ++tt) { f32x4 sc = {0.f, 0.f, 0.f, 0.f}; \
                if (tt <= (jt)) { f32x4 d = {0.f, 0.f, 0.f, 0.f}; const int trow = 16 * tt + l15; \
                    _Pragma("unroll") for (int ks = 0; ks < 4; ++ks) { const bf16x8 kf = *(LAS bf16x8*)(lds + M3_K + qo_ + tq_[ks] + 4096 * tt); d = __builtin_amdgcn_mfma_f32_16x16x32_bf16(kf, qb_[ks], d, 0, 0, 0); } \
                    const f32x4 a4 = *(LAS f32x4*)(A_ + MA_A / 4 + 16 * tt + 4 * g); \
                    _Pragma("unroll") for (int r = 0; r < 4; ++r) { const int t = 16 * tt + 4 * g + r; const float w = (t <= j) ? __builtin_amdgcn_exp2f(a4[r] - Mj) : 0.f; sc[r] = d[r] * w; rs += sc[r]; } } \
                u32x2 pk_; pk_.x = cvt2(sc[0], sc[1]); pk_.y = cvt2(sc[2], sc[3]); \
                *(LAS u32x2*)(lds + M3_SC + ((c) & 1) * 8192 + tw_[tt] + 2048 * (jt)) = pk_; } \
            rs += __shfl_xor(rs, 16); rs += __shfl_xor(rs, 32); \
            if (g == 0) aDEN[64 * ((c) & 1) + j] = rs; } while (0)
#define M3_SCORES(c) do { if (wid == 4) M3_SCORE_ROWS(c, 3); else if (wid == 5) M3_SCORE_ROWS(c, 2); else if (wid == 6) { M3_SCORE_ROWS(c, 1); M3_SCORE_ROWS(c, 0); } } while (0)
        if (MODE != 2) { M3_LOAD_QK(0, A); M3_LOAD_V(0, A); M3_LOAD_G(0, A); M3_WRITE_QK(0, A); M3_WRITE_V(0, A); M3_GATES(0, A);
        M3_LOAD_QK(1, A); M3_LOAD_G(1, A); M3_WRITE_QK(1, A); M3_GATES(1, A);
        M3_LOAD_QK(2, A); M3_LOAD_G(2, A); M3_LOAD_V(1, A); M3_LOAD_QK(3, B); M3_LOAD_G(3, B); M3_LOAD_V(2, B); }
        M3_BAR();
        if (MODE != 2) M3_SCORES(0);
        M3_BAR();
#define M3_TSTEP(c, S) do { \
            if ((c) + 2 < 64) M3_WRITE_QK((c) + 2, S); \
            if ((c) + 1 < 64) M3_WRITE_V((c) + 1, S); \
            if ((c) + 2 < 64) M3_GATES((c) + 2, S); \
            if ((c) + 4 < 64) { M3_LOAD_QK((c) + 4, S); M3_LOAD_G((c) + 4, S); } \
            if ((c) + 3 < 64) M3_LOAD_V((c) + 3, S); \
            if ((c) + 1 < 64) M3_SCORES((c) + 1); \
            M3_BAR(); } while (0)
#pragma nounroll
        for (int c = 0; c < 64; c += 2) {
            if (MODE == 2) { M3_BAR(); M3_BAR(); continue; }
            M3_TSTEP(c, A);
            M3_TSTEP(c + 1, B);
        }
#undef M3_TSTEP
    } else {
        const int s_ = wid;
        f32x4 C[8][2]; f32x4 nst[2] = {{0.f, 0.f, 0.f, 0.f}, {0.f, 0.f, 0.f, 0.f}};
#pragma unroll
        for (int T = 0; T < 8; ++T) { C[T][0] = (f32x4){0.f, 0.f, 0.f, 0.f}; C[T][1] = (f32x4){0.f, 0.f, 0.f, 0.f}; }
        M3_BAR();
        M3_BAR();
        const int q4 = l15 >> 2, p4 = l15 & 3;
        int qA[4], qB[4], kT[8], kN[2], sK[2], hoff;
        { const int swl = swc(l15), swt = q4 | ((g & 1) << 2), s2 = (l15 >> 1) & 7;
#pragma unroll
          for (int ks = 0; ks < 4; ++ks) { qA[ks] = l15 * 256 + (((2 * ks) ^ swl) << 5) + 8 * g; qB[ks] = l15 * 256 + (((2 * ks + 1) ^ swl) << 5) + 8 * g; }
#pragma unroll
          for (int T = 0; T < 8; ++T) kT[T] = (8 * g + q4) * 256 + ((T ^ swt) << 5) + 8 * p4;
#pragma unroll
          for (int tn = 0; tn < 2; ++tn) kN[tn] = (8 * g + q4) * 256 + (((2 * s_ + tn) ^ swt) << 5) + 8 * p4;
#pragma unroll
          for (int ks = 0; ks < 2; ++ks) sK[ks] = l15 * 128 + (((4 * ks + g) ^ s2) << 4);
          hoff = (dir ? 15 - l15 : l15) * 2048 + 8 * g;
#pragma unroll
          for (int ks = 0; ks < 4; ++ks) asm volatile("" : "+v"(qA[ks]), "+v"(qB[ks]));
#pragma unroll
          for (int T = 0; T < 8; ++T) asm volatile("" : "+v"(kT[T]));
          asm volatile("" : "+v"(kN[0]), "+v"(kN[1]), "+v"(sK[0]), "+v"(sK[1]), "+v"(hoff)); }
#pragma nounroll
        for (int c = 0; c < 64; ++c) {
            if (MODE == 1) { M3_BAR(); continue; }
            const int qo = (c % 3) * 16384, vo = (c & 1) * 16384, par = c & 1;
            LAS float* A_ = (LAS float*)(lds + M3_ARR + (c % 3) * M3_ARRS);
            LAS unsigned char* const Qb = lds + M3_Q + qo; LAS unsigned char* const Kb = lds + M3_K + qo; LAS unsigned char* const Vb = lds + M3_V + vo; LAS unsigned char* const Sb = lds + M3_SC + par * 8192;
            { f32x4 qn = {0.f, 0.f, 0.f, 0.f};
#pragma unroll
              for (int ks = 0; ks < 4; ++ks) {
                  const u32x2 a0 = *(LAS u32x2*)(Qb + s_ * 4096 + qA[ks]), a1 = *(LAS u32x2*)(Qb + s_ * 4096 + qB[ks]);
                  const f32x4 n0 = *(LAS f32x4*)(aNV + 32 * ks + 4 * g), n1 = *(LAS f32x4*)(aNV + 32 * ks + 16 + 4 * g);
                  u32x4 aw; aw.x = a0.x; aw.y = a0.y; aw.z = a1.x; aw.w = a1.y;
                  u32x4 bw; bw.x = cvt2(n0[0], n0[1]); bw.y = cvt2(n0[2], n0[3]); bw.z = cvt2(n1[0], n1[1]); bw.w = cvt2(n1[2], n1[3]);
                  qn = __builtin_amdgcn_mfma_f32_16x16x32_bf16(u4_to_b8(aw), u4_to_b8(bw), qn, 0, 0, 0); }
              if (l15 == 0) *(LAS f32x4*)(aQN + 16 * s_ + 4 * g) = qn;
              asm volatile("s_waitcnt lgkmcnt(0)" ::: "memory");
              if (lane == 0) aFLAG[s_] = (unsigned)(c + 1);
              asm volatile("" ::: "memory"); }
            bf16x8 vb[2][2], Cb[4][2];
#pragma unroll
            for (int nt = 0; nt < 2; ++nt) {
#pragma unroll
                for (int ks = 0; ks < 2; ++ks) vb[ks][nt] = cat8(tr16(Vb + kN[nt] + ks * 8192), tr16(Vb + kN[nt] + ks * 8192 + 1024));
#pragma unroll
                for (int ks = 0; ks < 4; ++ks) { u32x4 w; w.x = cvt2(C[2 * ks][nt][0], C[2 * ks][nt][1]); w.y = cvt2(C[2 * ks][nt][2], C[2 * ks][nt][3]); w.z = cvt2(C[2 * ks + 1][nt][0], C[2 * ks + 1][nt][1]); w.w = cvt2(C[2 * ks + 1][nt][2], C[2 * ks + 1][nt][3]); Cb[ks][nt] = u4_to_b8(w); } }
#pragma unroll
            for (int mt = 0; mt < 4; ++mt) { const int j = 16 * mt + l15;
                f32x4 sv[2] = {{0.f, 0.f, 0.f, 0.f}, {0.f, 0.f, 0.f, 0.f}}, in[2] = {{0.f, 0.f, 0.f, 0.f}, {0.f, 0.f, 0.f, 0.f}};
#pragma unroll
                for (int ks = 0; ks < 2; ++ks) if (ks == 0 || mt >= 2) { const bf16x8 af = *(LAS bf16x8*)(Sb + sK[ks] + mt * 2048);
                    sv[0] = __builtin_amdgcn_mfma_f32_16x16x32_bf16(vb[ks][0], af, sv[0], 0, 0, 0); sv[1] = __builtin_amdgcn_mfma_f32_16x16x32_bf16(vb[ks][1], af, sv[1], 0, 0, 0); }
#pragma unroll
                for (int ks = 0; ks < 4; ++ks) {
                    const u32x2 a0 = *(LAS u32x2*)(Qb + qA[ks] + mt * 4096), a1 = *(LAS u32x2*)(Qb + qB[ks] + mt * 4096);
                    u32x4 aw; aw.x = a0.x; aw.y = a0.y; aw.z = a1.x; aw.w = a1.y;
                    in[0] = __builtin_amdgcn_mfma_f32_16x16x32_bf16(Cb[ks][0], u4_to_b8(aw), in[0], 0, 0, 0); in[1] = __builtin_amdgcn_mfma_f32_16x16x32_bf16(Cb[ks][1], u4_to_b8(aw), in[1], 0, 0, 0); }
                if (mt == 0) {
                    for (;;) { asm volatile("" ::: "memory"); const u32x4 f = *(LAS u32x4*)aFLAG; const unsigned mn = min(min(f.x, f.y), min(f.z, f.w));
                        if (__builtin_amdgcn_readfirstlane((int)mn) >= c + 1) break; __builtin_amdgcn_s_sleep(1); } }
                const float wi = A_[MA_WI / 4 + j], den = aDEN[64 * par + j] + wi * aQN[j];
                const float inv = __builtin_amdgcn_rcpf(fmaxf(fabsf(den), A_[MA_EN / 4 + j]));
                char* const ub = (char*)(HS + (rowbase + (size_t)(dir ? SEQ - 16 - (64 * c + 16 * mt) : 64 * c + 16 * mt)) * 1024 + h * 256 + dvh * 128 + 32 * s_);
#pragma unroll
                for (int nt = 0; nt < 2; ++nt) { u32x2 o; o.x = cvt2((sv[nt][0] + wi * in[nt][0]) * inv, (sv[nt][1] + wi * in[nt][1]) * inv); o.y = cvt2((sv[nt][2] + wi * in[nt][2]) * inv, (sv[nt][3] + wi * in[nt][3]) * inv);
                    *(u32x2*)(ub + (unsigned)hoff + 32 * nt) = o; } }
            { const float decay = A_[MA_SCAL / 4];
              bf16x8 vw[2][2]; bf16x8 wkb[2];
#pragma unroll
              for (int ks = 0; ks < 2; ++ks) { const f32x4 w0 = *(LAS f32x4*)(A_ + MA_WK / 4 + 32 * ks + 8 * g), w1 = *(LAS f32x4*)(A_ + MA_WK / 4 + 32 * ks + 8 * g + 4);
#pragma unroll
                  for (int nt = 0; nt < 2; ++nt) { const u32x4 v = __builtin_bit_cast(u32x4, vb[ks][nt]); u32x4 o;
                      o.x = cvt2(bflo(v.x) * w0[0], bfhi(v.x) * w0[1]); o.y = cvt2(bflo(v.y) * w0[2], bfhi(v.y) * w0[3]); o.z = cvt2(bflo(v.z) * w1[0], bfhi(v.z) * w1[1]); o.w = cvt2(bflo(v.w) * w1[2], bfhi(v.w) * w1[3]);
                      vw[ks][nt] = u4_to_b8(o); }
                  u32x4 wk; wk.x = cvt2(w0[0], w0[1]); wk.y = cvt2(w0[2], w0[3]); wk.z = cvt2(w1[0], w1[1]); wk.w = cvt2(w1[2], w1[3]); wkb[ks] = u4_to_b8(wk); }
              f32x4 nacc[2] = {{0.f, 0.f, 0.f, 0.f}, {0.f, 0.f, 0.f, 0.f}};
#pragma unroll
              for (int tn = 0; tn < 2; ++tn)
#pragma unroll
                  for (int ks = 0; ks < 2; ++ks) { const bf16x8 kf = cat8(tr16(Kb + kN[tn] + ks * 8192), tr16(Kb + kN[tn] + ks * 8192 + 1024));
                      nacc[tn] = __builtin_amdgcn_mfma_f32_16x16x32_bf16(kf, wkb[ks], nacc[tn], 0, 0, 0); }
#pragma unroll
              for (int T = 0; T < 8; ++T) { C[T][0] = C[T][0] * decay; C[T][1] = C[T][1] * decay;
#pragma unroll
                  for (int ks = 0; ks < 2; ++ks) { const bf16x8 kf = cat8(tr16(Kb + kT[T] + ks * 8192), tr16(Kb + kT[T] + ks * 8192 + 1024));
                      C[T][0] = __builtin_amdgcn_mfma_f32_16x16x32_bf16(kf, vw[ks][0], C[T][0], 0, 0, 0); C[T][1] = __builtin_amdgcn_mfma_f32_16x16x32_bf16(kf, vw[ks][1], C[T][1], 0, 0, 0); } }
#pragma unroll
              for (int tn = 0; tn < 2; ++tn) { nst[tn] = nst[tn] * decay + nacc[tn]; if (l15 == 0) *(LAS f32x4*)(aNV + 16 * (2 * s_ + tn) + 4 * g) = nst[tn]; } }
            M3_BAR();
        }
    }
#undef M3_GROW
#undef M3_BAR
#undef M3_LOAD_QK
#undef M3_CBASE
#undef M3_LOAD_V
#undef M3_LOAD_G
#undef M3_WRITE_QK
#undef M3_WRITE_V
#undef M3_GATES
#undef M3_SCORE_ROWS
#undef M3_SCORES
}
}
struct Args { const float* in[25]; float* out; unsigned char* ws; int ph_lo, ph_hi, li, pad; };
__device__ __forceinline__ float wave_sum(float v) {
#pragma unroll
    for (int o = 1; o < 64; o <<= 1) v += __shfl_xor(v, o);
    return v;
}
__device__ __forceinline__ int colmap(int map, int n) {
    if (map == 1) { const int pn = n >> 8, r = n & 255; return (r >> 7) * FFN + 128 * pn + (r & 127); }
    if (map == 2) { if (n >= 3840) return (n < 3856) ? n : -1;
                    if (n < 640 && (n & 63) < 16) { const int p = n & 15; return (n - p) + 4 * (p >> 3) + 8 * ((p >> 2) & 1) + (p & 3); } return n; }
    if (map == 3) return 3856 + n;
    return n;
}
__device__ __forceinline__ float colscale(int map, int n) {
    if (map == 1) return ((n & 255) < 128) ? -1.4426950408889634f : -0.6931471805599453f;
    if (map == 2) return (n >= 2816 && n < 3840) ? -1.4426950408889634f : 1.0f;
    if (map == 3 || map == 4) return -1.4426950408889634f;
    return 1.0f;
}
__device__ __forceinline__ void p0_item3(const float* __restrict__ W, int K, int Nsrc, int Ndst, bf16* __restrict__ WT, const float* __restrict__ gain, int map, int item, int lane_, LAS float* T) {
    const int nblk = Ndst / 64, kb = item / nblk, nb = item % nblk, k0 = 64 * kb, n0 = 64 * nb;
    const int c4 = lane_ & 15, kr = lane_ >> 4;
    const int sc = colmap(map, n0 + 4 * c4); const float cs = colscale(map, n0 + 4 * c4);
    f32x4 v[16];
#pragma unroll
    for (int i = 0; i < 16; ++i) { v[i] = (f32x4){0.f, 0.f, 0.f, 0.f}; if (sc >= 0) v[i] = __builtin_nontemporal_load((const GAS f32x4*)(W + (size_t)(k0 + 4 * i + kr) * Nsrc + sc)); }
#pragma unroll
    for (int i = 0; i < 16; ++i) { const int k = 4 * i + kr; float g = cs; if (gain) g = gain[k0 + k] * cs;
        *(LAS f32x4*)(T + k * 64 + ((c4 ^ ((k >> 3) & 7)) << 2)) = v[i] * g; }
    LDS_WAIT(); asm volatile("" ::: "memory");
    const int oct = lane_ & 7;
#pragma unroll
    for (int j = 0; j < 8; ++j) { const int n = (lane_ >> 3) + 8 * j; const int col = (((n >> 2) ^ oct) << 2) | (n & 3);
        const LAS float* t = T + (8 * oct) * 64 + col;
        v4u o; o.x = pk2(t[0], t[64]); o.y = pk2(t[128], t[192]); o.z = pk2(t[256], t[320]); o.w = pk2(t[384], t[448]);
        *(GAS v4u*)(WT + (size_t)(n0 + n) * K + k0 + 8 * oct) = o; }
    LDS_WAIT(); asm volatile("" ::: "memory");
}
__global__ void __launch_bounds__(NWAVES * 64, 2) mk_fwd(Args args) {
    extern __shared__ __attribute__((aligned(16))) unsigned char lds[];
    LAS unsigned char* const L = (LAS unsigned char*)lds;
    volatile LAS unsigned* const MISC = (volatile LAS unsigned*)(L + MISC_OFF);
    const int wave = __builtin_amdgcn_readfirstlane((int)threadIdx.x >> 6);
#define tid (wave * 64 + lane_id())
#define lane (lane_id())
    const int G = gridDim.x; const int bx = blockIdx.x; const int vcu = (G % 8 == 0) ? (bx % 8) * (G / 8) + bx / 8 : bx;
    unsigned char* const ws = args.ws;
    gu32* const ctl = (gu32*)(ws + WS_CTL);
    for (int u = tid; u < (LDS_BYTES - LDSCTL_OFF) / 4; u += NWAVES * 64) ((LAS unsigned*)(L + LDSCTL_OFF))[u] = 0u;
    __syncthreads();
    XcdBarrier bar = xcd_barrier_post((unsigned*)(ctl + CW_BAR) + args.li * XCD_BAR_WORDS, MISC + 8, wave);
    const int lo = args.ph_lo, hi = args.ph_hi;
    bf16* const XN = (bf16*)(ws + WS_XN);
    float* const INV = (float*)(ws + WS_SSQ);
    float* const ROPE_C = (float*)(ws + WS_ROPE); float* const ROPE_S = ROPE_C + SEQ * 8;
    const int gw = vcu * NWAVES + wave, NGW = G * NWAVES;

#define IN(k) (lo <= (k) && (k) < hi)
#define SEAM(k) do { if (lo <= (k) && (k) + 1 < hi) xcd_barrier(bar); } while (0)
    if (IN(0)) {
        {
        {
            struct WD { int src; int K, Nsrc, Ndst; size_t dst; int gain; int map; };
            const WD wd[11] = { {3, 1024, 5632, 5632, WS_W1A, 2, 1}, {4, 2816, 1024, 1024, WS_W2A, -1, 0}, {7, 1024, INW, 4096, WS_WINA, 6, 2}, {7, 1024, INW, 2048, WS_WINB, 6, 3},
                                {13, 512, 1024, 1024, WS_WBA, -1, 0}, {14, 1024, 1024, 1024, WS_WBM, -1, 0}, {15, 1024, 1024, 1024, WS_WOUT, -1, 0},
                                {18, 1024, 5632, 5632, WS_W1B, 17, 1}, {19, 2816, 1024, 1024, WS_W2B, -1, 0}, {22, 1024, 1024, 1024, WS_WPG, 21, 4}, {23, 256, 1024, 1024, WS_WPP, -1, 0} };
            int base_it = 0;
            LAS float* Tw = (LAS float*)(L + RING_OFF + wave * 16384);
#pragma unroll
            for (int w = 0; w < 11; ++w) { const int ni = (wd[w].K / 64) * (wd[w].Ndst / 64);
                int first = gw - (base_it % NGW); if (first < 0) first += NGW;
                for (int r = first; r < ni; r += NGW)
                    p0_item3(args.in[wd[w].src], wd[w].K, wd[w].Nsrc, wd[w].Ndst, (bf16*)(ws + wd[w].dst), wd[w].gain >= 0 ? args.in[wd[w].gain] : nullptr, wd[w].map, r, lane, Tw);
                base_it += ni; }
        }
        {
            {
                const float* x = args.in[0];
                for (int m0 = gw * 4; m0 < M; m0 += NGW * 4) {
                    f32x4 v[4][4];
#pragma unroll
                    for (int rr = 0; rr < 4; ++rr) { const GAS f32x4* xr = (const GAS f32x4*)(x + (size_t)(m0 + rr) * DM) + lane;
#pragma unroll
                        for (int j = 0; j < 4; ++j) v[rr][j] = __builtin_nontemporal_load(xr + 64 * j); }
#pragma unroll
                    for (int rr = 0; rr < 4; ++rr) { float s = 0.f;
#pragma unroll
                        for (int j = 0; j < 4; ++j) s += (v[rr][j].x * v[rr][j].x + v[rr][j].y * v[rr][j].y) + (v[rr][j].z * v[rr][j].z + v[rr][j].w * v[rr][j].w);
                        s = wave_sum(s);
                        const float r = rsqrtf(s * (1.f / 1024.f) + pg8::RMS_EPS);
                        if (lane == 0) INV[m0 + rr] = 1.0f / r;
                        GAS unsigned long long* o8 = (GAS unsigned long long*)(XN + (size_t)(m0 + rr) * DM) + lane;
#pragma unroll
                        for (int j = 0; j < 4; ++j) o8[64 * j] = (unsigned long long)pk2(v[rr][j].x * r, v[rr][j].y * r) | ((unsigned long long)pk2(v[rr][j].z * r, v[rr][j].w * r) << 32); }
                } }
        }
        {
            { const float* p = args.in[1]; bf16* PB = (bf16*)(ws + WS_PB);
                const size_t NP = (size_t)M * PLE_DIM / 4, stride = (size_t)NGW * 64;
                for (size_t i0 = (size_t)(gw * 64 + lane); i0 < NP; i0 += 4 * stride) { f32x4 v[4];
#pragma unroll
                    for (int k = 0; k < 4; ++k) if (i0 + k * stride < NP) v[k] = __builtin_nontemporal_load((const GAS f32x4*)(p + (i0 + k * stride) * 4));
#pragma unroll
                    for (int k = 0; k < 4; ++k) if (i0 + k * stride < NP) *(GAS unsigned long long*)(PB + (i0 + k * stride) * 4) = (unsigned long long)pk2(v[k].x, v[k].y) | ((unsigned long long)pk2(v[k].z, v[k].w) << 32); } }
        }
        {
            {
                for (int i = bx * (NWAVES * 64) + tid; i < (int)(4 * MiB / 16); i += G * NWAVES * 64) ((GAS v4u*)(ws + WS_XBUF))[i] = (v4u){0u, 0u, 0u, 0u}; }
            {
                const int t = bx * (NWAVES * 64) + tid;
                if ((t & 3) == 0 && (t >> 2) < SEQ * 8) { const int i = t >> 2, pos = i >> 3, j = i & 7;
                    const float invs[8] = {(float)1.0, (float)0.19392274474868576, (float)0.03760603093086393, (float)0.007292664737217109, (float)0.001414213562373095, (float)0.0002742481756762073, (float)5.318295896944988e-05, (float)1.031338537721246e-05};
                    float inv = invs[0];
#pragma unroll
                    for (int k = 1; k < 8; ++k) inv = (j == k) ? invs[k] : inv;
                    const float ang = (float)pos * inv;
                    ROPE_C[i] = (float)cos((double)ang); ROPE_S[i] = (float)sin((double)ang); } }
        }
        }
    }
    SEAM(0);
    if (IN(1)) { pg8::Gemm g{XN, (const bf16*)(ws + WS_W1A), M, 2 * FFN, DM}; pg8::StaticOrder S; S.init(M, 2 * FFN, G, bx);
        pg8::EpiSwiglu E{(bf16*)(ws + WS_H)};
        pg8::gemm_phase<DM, pg8::EpiSwiglu, pg8::StaticOrder, true, true>(L + RING_OFF, g, S, E, wave);
        }
#ifdef PROBE_G2
    { xcd_barrier(bar);
        pg8::Gemm g{(const bf16*)(ws + WS_H), (const bf16*)(ws + WS_W2A), M, DM, FFN}; pg8::StaticOrder S; S.init(M, DM, G, bx);
        pg8::EpiSwigluT<2> E{(bf16*)(ws + WS_H)};
        pg8::gemm_phase<FFN, pg8::EpiSwigluT<2>, pg8::StaticOrder, true, true>(L + RING_OFF, g, S, E, wave); }
    { xcd_barrier(bar);
        pg8::Gemm g{(const bf16*)(ws + WS_H), (const bf16*)(ws + WS_W2A), M, DM, FFN}; pg8::StaticOrder S; S.init(M, DM, G, bx);
        pg8::EpiSwigluT<2> E{(bf16*)(ws + WS_H)};
        pg8::gemm_phase<FFN, pg8::EpiSwigluT<2>, pg8::StaticOrder, true, true>(L + RING_OFF, g, S, E, wave); }
#endif
#ifdef PROBE_G1
    { xcd_barrier(bar);
        pg8::Gemm g{XN, (const bf16*)(ws + WS_W1A), M, 2 * FFN, DM}; pg8::StaticOrder S; S.init(M, 2 * FFN, G, bx);
        pg8::EpiSwigluT<PROBE_G1 - 1> E{(bf16*)(ws + WS_H)};
        pg8::gemm_phase<DM, pg8::EpiSwigluT<PROBE_G1 - 1>, pg8::StaticOrder, true, true>(L + RING_OFF, g, S, E, wave); }
    { xcd_barrier(bar);
        pg8::Gemm g{XN, (const bf16*)(ws + WS_W1A), M, 2 * FFN, DM}; pg8::StaticOrder S; S.init(M, 2 * FFN, G, bx);
        pg8::EpiSwigluT<PROBE_G1 - 1> E{(bf16*)(ws + WS_H)};
        pg8::gemm_phase<DM, pg8::EpiSwigluT<PROBE_G1 - 1>, pg8::StaticOrder, true, true>(L + RING_OFF, g, S, E, wave); }
#endif
    SEAM(1);
    if (IN(2)) { const unsigned poison = (unsigned)__builtin_amdgcn_readfirstlane((int)(__hip_atomic_load(ctl + CW_TMO, RLX_AGENT) != 0u));
        pg8::Gemm g{(const bf16*)(ws + WS_H), (const bf16*)(ws + WS_W2A), M, DM, FFN};
#pragma nounroll
        for (int rd = 0; rd < 2; ++rd) { pg8::PanelSsq st{(unsigned*)(ws + WS_XBUF), (unsigned*)(ctl + CW_SEAM), (unsigned*)(ctl + CW_TMO), 0x700u}, st2{(unsigned*)(ws + WS_XBUF) + (size_t)4 * M * 4, (unsigned*)(ctl + CW_SEAM + 4 * SEAM_BANK), (unsigned*)(ctl + CW_TMO), 0x800u}; pg8::EpiRmsRes E{XN, INV, INV + M, args.in[5], 0.5f, st, st2, poison};
            pg8::RoundOrder S; S.so.init(M, DM, G, bx); S.round = rd;
            pg8::gemm_phase<FFN, pg8::EpiRmsRes, pg8::RoundOrder, false, true>(L + RING_OFF, g, S, E, wave); __syncthreads(); } }
    SEAM(2);
    if (IN(3)) { pg8::Gemm g{XN, (const bf16*)(ws + WS_WINA), M, 4096, DM}; pg8::StaticOrder S; S.init(M, 4096, G, bx);
        pg8::EpiRoute E{(bf16*)(ws + WS_AQ), (bf16*)(ws + WS_AKV), (bf16*)(ws + WS_MQK), (bf16*)(ws + WS_MV), (bf16*)(ws + WS_MO), (float*)(ws + WS_GATES), ROPE_C, ROPE_S, args.in[8]};
        pg8::gemm_phase<DM, pg8::EpiRoute, pg8::StaticOrder, true, true>(L + RING_OFF, g, S, E, wave); }
    SEAM(3);
    if (IN(4)) {
            const bf16* MQK = (const bf16*)(ws + WS_MQK); bf16* CQK = (bf16*)(ws + WS_CQK); const float* cw = args.in[9]; const float* cb = args.in[10];
            for (int it = bx * (NWAVES * 64) + tid; it < (M / 16) * 128; it += G * NWAVES * 64) {
                const int cg = it & 127, rb = it >> 7, c0 = cg * 8, r0 = rb * 16, s0 = r0 & (SEQ - 1);
                pg8::u32x4 raw[20];
#pragma unroll
                for (int i = 0; i < 20; ++i) { const int sp = s0 - 2 + i; raw[i] = (pg8::u32x4){0u, 0u, 0u, 0u}; if (sp >= 0 && sp < SEQ) raw[i] = *(const pg8::u32x4*)(MQK + (size_t)(r0 - 2 + i) * 1024 + c0); }
                float wgt[5][8], bias[8];
#pragma unroll
                for (int j = 0; j < 5; ++j) { const f32x4 a = *(const f32x4*)(cw + j * 1024 + c0), b = *(const f32x4*)(cw + j * 1024 + c0 + 4);
                    wgt[j][0] = a[0]; wgt[j][1] = a[1]; wgt[j][2] = a[2]; wgt[j][3] = a[3]; wgt[j][4] = b[0]; wgt[j][5] = b[1]; wgt[j][6] = b[2]; wgt[j][7] = b[3]; }
                { const f32x4 a = *(const f32x4*)(cb + c0), b = *(const f32x4*)(cb + c0 + 4); bias[0] = a[0]; bias[1] = a[1]; bias[2] = a[2]; bias[3] = a[3]; bias[4] = b[0]; bias[5] = b[1]; bias[6] = b[2]; bias[7] = b[3]; }
                const float osc = (c0 >= 512) ? 0.08838834764831845f : 1.0f;
#pragma unroll
                for (int o = 0; o < 16; ++o) { float acc8[8];
#pragma unroll
                    for (int e = 0; e < 8; ++e) acc8[e] = bias[e];
#pragma unroll
                    for (int j = 0; j < 5; ++j) { pg8::f32x4 a, b; pg8::unpack8(raw[o + j], a, b);
#pragma unroll
                        for (int e = 0; e < 4; ++e) { acc8[e] += a[e] * wgt[j][e]; acc8[4 + e] += b[e] * wgt[j][4 + e]; } }
                    pg8::f32x4 o0, o1;
#pragma unroll
                    for (int e = 0; e < 4; ++e) { o0[e] = acc8[e] * pg8::fsigmoid(acc8[e]) * osc; o1[e] = acc8[4 + e] * pg8::fsigmoid(acc8[4 + e]) * osc; }
                    *(pg8::u32x4*)(CQK + (size_t)(r0 + o) * 1024 + c0) = pg8::pack8(o0, o1); }
            }
    }
    SEAM(4);
    if (IN(5)) {
#ifdef PROBE_ML
        if (bx < 128) mix::mlstm_item3<PROBE_ML>(((((bx >> 3) >> 1) * 8 + (bx & 7)) << 1) | ((bx >> 3) & 1), L, (const bf16*)(ws + WS_CQK), (const bf16*)(ws + WS_MV), (const float*)(ws + WS_GATES), (bf16*)(ws + WS_HSF), (bf16*)(ws + WS_HSB), tid);
        xcd_barrier(bar);
#endif
#ifdef PROBE_AT
        if (bx >= 128) mix::attn_run(((bx - 128) & 7) * 16 + ((bx - 128) >> 3), G - 128, 1024, L, (const bf16*)(ws + WS_AQ), (const bf16*)(ws + WS_AKV), (bf16*)(ws + WS_T1), args.in[11], tid);
        xcd_barrier(bar);
#endif
        const int mitem = ((((bx >> 3) >> 1) * 8 + (bx & 7)) << 1) | ((bx >> 3) & 1);
        if (bx < 128) { mix::mlstm_item3(mitem, L, (const bf16*)(ws + WS_CQK), (const bf16*)(ws + WS_MV), (const float*)(ws + WS_GATES), (bf16*)(ws + WS_HSF), (bf16*)(ws + WS_HSB), tid);
            { const int grp = mitem >> 2, qtr = mitem & 3; gu32* cnt = ctl + CW_HMG + 64 * grp;
              VM_WAIT(); __syncthreads();
              if (tid == 0) { __builtin_amdgcn_fence(__ATOMIC_RELEASE, "agent"); VM_WAIT(); __hip_atomic_fetch_add(cnt, 1u, RLX_AGENT);
                  unsigned sp = 0; while (__hip_atomic_load(cnt, RLX_AGENT) < 4u) { __builtin_amdgcn_s_sleep(8); if (++sp > (1u << 22)) { __hip_atomic_store(ctl + CW_TMO, 1u, RLX_AGENT); break; } }
                  __builtin_amdgcn_fence(__ATOMIC_ACQUIRE, "agent"); VM_WAIT(); }
              __syncthreads();
              const bf16* HSF = (const bf16*)(ws + WS_HSF); const bf16* HSB = (const bf16*)(ws + WS_HSB); bf16* HM = (bf16*)(ws + WS_HM); const float* gn = args.in[12];
              const int hh = grp & 3; const size_t rb0 = (size_t)(grp >> 2) * SEQ + qtr * 1024 + wave * 128;
              const int hl = lane & 31, rsel = lane >> 5;
              const pg8::f32x4 gg0 = *(const pg8::f32x4*)(gn + hh * 256 + hl * 8), gg1 = *(const pg8::f32x4*)(gn + hh * 256 + hl * 8 + 4);
#pragma nounroll
              for (int r0 = 0; r0 < 128; r0 += 16) {
                  pg8::u32x4 qa[8], qb[8], qg[8];
#pragma unroll
                  for (int i = 0; i < 8; ++i) { const size_t o = (rb0 + r0 + 2 * i + rsel) * 1024 + hh * 256 + hl * 8;
                      qa[i] = *(const pg8::u32x4*)(HSF + o); qb[i] = *(const pg8::u32x4*)(HSB + o); qg[i] = *(const pg8::u32x4*)(HM + o); }
#pragma unroll
                  for (int i = 0; i < 8; ++i) { pg8::f32x4 a0, a1, b0, b1, g0, g1; pg8::unpack8(qa[i], a0, a1); pg8::unpack8(qb[i], b0, b1); pg8::unpack8(qg[i], g0, g1);
                      const pg8::f32x4 v0 = a0 + b0, v1 = a1 + b1;
                      float ss = ((v0[0] * v0[0] + v0[1] * v0[1]) + (v0[2] * v0[2] + v0[3] * v0[3])) + ((v1[0] * v1[0] + v1[1] * v1[1]) + (v1[2] * v1[2] + v1[3] * v1[3]));
#pragma unroll
                      for (int o = 1; o < 32; o <<= 1) ss += __shfl_xor(ss, o);
                      const float r = rsqrtf(ss * (1.f / 256.f) + pg8::RMS_EPS);
                      *(pg8::u32x4*)(HM + (rb0 + r0 + 2 * i + rsel) * 1024 + hh * 256 + hl * 8) = pg8::pack8(v0 * r * gg0 * g0, v1 * r * gg1 * g1); }
              } }
            pg8::Gemm g{XN, (const bf16*)(ws + WS_WINB), M, 2048, DM}; pg8::QueueOrder S; S.so.init(M, 2048, 1, 0); S.xlab = bx & 7; S.ctr = (unsigned*)(ctl + CW_G3BQ + 64 * (bx & 7)); S.limit = 1024; S.slot = (LAS int*)(L + 131072 + 12288); S.wave = wave;
            pg8::EpiSig E{(bf16*)args.out, (bf16*)args.out + (size_t)M * 1024};
            pg8::gemm_phase<DM, pg8::EpiSig, pg8::QueueOrder, true, true>(L + RING_OFF, g, S, E, wave); }
        if (bx >= 128) { mix::attn_run(((bx - 128) & 7) * 16 + ((bx - 128) >> 3), G - 128, 1024, L, (const bf16*)(ws + WS_AQ), (const bf16*)(ws + WS_AKV), (bf16*)(ws + WS_AQ), args.in[11], tid);
            pg8::Gemm g{XN, (const bf16*)(ws + WS_WINB), M, 2048, DM}; pg8::QueueOrder S; S.so.init(M, 2048, 1, 0); S.xlab = bx & 7; S.ctr = (unsigned*)(ctl + CW_G3BQ + 64 * (bx & 7)); S.limit = 1024; S.slot = (LAS int*)(L + 131072 + 12288); S.wave = wave;
            pg8::EpiSig E{(bf16*)args.out, (bf16*)args.out + (size_t)M * 1024};
            pg8::gemm_phase<DM, pg8::EpiSig, pg8::QueueOrder, true, true>(L + RING_OFF, g, S, E, wave); }
    }
    SEAM(5);
    if (IN(8)) {
        { pg8::Gemm g{(const bf16*)(ws + WS_AQ), (const bf16*)(ws + WS_WBA), M, DM, 512}; pg8::StaticOrder S; S.init(M, DM, G, bx);
          pg8::EpiMul<false> E{(bf16*)(ws + WS_T1), (const bf16*)args.out, nullptr};
          pg8::gemm_phase<512, pg8::EpiMul<false>, pg8::StaticOrder, true, true>(L + RING_OFF, g, S, E, wave); }
        VM_WAIT(); __syncthreads();
        { pg8::Gemm g{(const bf16*)(ws + WS_HM), (const bf16*)(ws + WS_WBM), M, DM, DM}; pg8::StaticOrder S; S.init(M, DM, G, bx);
          pg8::EpiMul<true> E{(bf16*)(ws + WS_MG), (const bf16*)args.out + (size_t)M * 1024, (const bf16*)(ws + WS_T1)};
          pg8::gemm_phase<DM, pg8::EpiMul<true>, pg8::StaticOrder, true, true>(L + RING_OFF, g, S, E, wave); } }
    SEAM(8);
    if (IN(9)) { const unsigned poison = (unsigned)__builtin_amdgcn_readfirstlane((int)(__hip_atomic_load(ctl + CW_TMO, RLX_AGENT) != 0u));
        pg8::Gemm g{(const bf16*)(ws + WS_MG), (const bf16*)(ws + WS_WOUT), M, DM, DM};
#pragma nounroll
        for (int rd = 0; rd < 2; ++rd) { pg8::PanelSsq st{(unsigned*)(ws + WS_XBUF) + (size_t)1 * M * 4, (unsigned*)(ctl + CW_SEAM + 1 * SEAM_BANK), (unsigned*)(ctl + CW_TMO), 0x740u}, st2{(unsigned*)(ws + WS_XBUF) + (size_t)5 * M * 4, (unsigned*)(ctl + CW_SEAM + 5 * SEAM_BANK), (unsigned*)(ctl + CW_TMO), 0x840u}; pg8::EpiRmsRes E{XN, INV + M, INV + 2 * M, args.in[16], 1.0f, st, st2, poison};
            pg8::RoundOrder S; S.so.init(M, DM, G, bx); S.round = rd;
            pg8::gemm_phase<DM, pg8::EpiRmsRes, pg8::RoundOrder, false, true>(L + RING_OFF, g, S, E, wave); __syncthreads(); } }
    SEAM(9);
    if (IN(10)) { pg8::Gemm g{XN, (const bf16*)(ws + WS_W1B), M, 2 * FFN, DM}; pg8::StaticOrder S; S.init(M, 2 * FFN, G, bx);
        pg8::EpiSwiglu E{(bf16*)(ws + WS_H)};
        pg8::gemm_phase<DM, pg8::EpiSwiglu, pg8::StaticOrder, true, true>(L + RING_OFF, g, S, E, wave); }
    SEAM(10);
    if (IN(11)) { const unsigned poison = (unsigned)__builtin_amdgcn_readfirstlane((int)(__hip_atomic_load(ctl + CW_TMO, RLX_AGENT) != 0u));
        pg8::Gemm g{(const bf16*)(ws + WS_H), (const bf16*)(ws + WS_W2B), M, DM, FFN};
#pragma nounroll
        for (int rd = 0; rd < 2; ++rd) { pg8::PanelSsq st{(unsigned*)(ws + WS_XBUF) + (size_t)2 * M * 4, (unsigned*)(ctl + CW_SEAM + 2 * SEAM_BANK), (unsigned*)(ctl + CW_TMO), 0x780u}, st2{(unsigned*)(ws + WS_XBUF) + (size_t)6 * M * 4, (unsigned*)(ctl + CW_SEAM + 6 * SEAM_BANK), (unsigned*)(ctl + CW_TMO), 0x880u}; pg8::EpiRmsRes E{XN, INV + 2 * M, INV + 3 * M, args.in[20], 0.5f, st, st2, poison};
            pg8::RoundOrder S; S.so.init(M, DM, G, bx); S.round = rd;
            pg8::gemm_phase<FFN, pg8::EpiRmsRes, pg8::RoundOrder, false, true>(L + RING_OFF, g, S, E, wave); __syncthreads(); } }
    SEAM(11);
    if (IN(12)) {
        { pg8::Gemm g{(const bf16*)(ws + WS_PB), (const bf16*)(ws + WS_WPP), M, DM, PLE_DIM}; pg8::StaticOrder S; S.init(M, DM, G, bx);
          pg8::EpiPlainNP E{(bf16*)(ws + WS_PR)};
          pg8::gemm_phase<PLE_DIM, pg8::EpiPlainNP, pg8::StaticOrder, true, true>(L + RING_OFF, g, S, E, wave); }
        VM_WAIT(); __syncthreads();
        const unsigned poison = (unsigned)__builtin_amdgcn_readfirstlane((int)(__hip_atomic_load(ctl + CW_TMO, RLX_AGENT) != 0u));
        pg8::Gemm g{XN, (const bf16*)(ws + WS_WPG), M, DM, DM};
#pragma nounroll
        for (int rd = 0; rd < 2; ++rd) { pg8::PanelSsq st{(unsigned*)(ws + WS_XBUF) + (size_t)3 * M * 4, (unsigned*)(ctl + CW_SEAM + 3 * SEAM_BANK), (unsigned*)(ctl + CW_TMO), 0x7c0u}; pg8::EpiPle E{XN, INV + 3 * M, args.out, (const bf16*)(ws + WS_PR), args.in[24], st, poison};
            pg8::RoundOrder S; S.so.init(M, DM, G, bx); S.round = rd;
            pg8::gemm_phase<DM, pg8::EpiPle, pg8::RoundOrder, false, true>(L + RING_OFF, g, S, E, wave); __syncthreads(); } }
#undef IN
#undef tid
#undef lane
#undef SEAM
}
extern "C" void kernel_launch(void* const* d_in, const int* in_sizes, int n_in, void* d_out, int out_size, void* d_ws, size_t ws_size, hipStream_t stream) {
    static int grid = 0;
    if (grid == 0) {
        if (n_in != 25 || in_sizes[0] != M * DM || out_size != M * DM || ws_size < WS_END) { fprintf(stderr, "kernel_launch: unexpected shapes (n_in %d, in0 %d, out %d, ws %zu)\n", n_in, n_in > 0 ? in_sizes[0] : -1, out_size, ws_size); grid = -1; return; }
        int dev = 0, cus = 0, per_cu = 0;
        if (hipGetDevice(&dev) != hipSuccess || hipDeviceGetAttribute(&cus, hipDeviceAttributeMultiprocessorCount, dev) != hipSuccess) { grid = -1; return; }
        if (hipFuncSetAttribute((const void*)mk_fwd, hipFuncAttributeMaxDynamicSharedMemorySize, LDS_BYTES) != hipSuccess) { fprintf(stderr, "kernel_launch: hipFuncSetAttribute failed\n"); grid = -1; return; }
        if (hipOccupancyMaxActiveBlocksPerMultiprocessor(&per_cu, (const void*)mk_fwd, NWAVES * 64, LDS_BYTES) != hipSuccess || per_cu < 1) { fprintf(stderr, "kernel_launch: occupancy query says %d\n", per_cu); per_cu = 1; }
        (void)hipGetLastError();
        grid = cus;
        if (grid != 256) fprintf(stderr, "kernel_launch: %d CUs; the fused epilogues need a 256-workgroup grid\n", grid);
    }
    if (grid < 0) return;
    (void)hipMemsetAsync((char*)d_ws + WS_CTL, 0, CTL_ZERO_BYTES, stream);
    Args a{};
    for (int i = 0; i < 25; ++i) a.in[i] = (const float*)d_in[i];
    a.out = (float*)d_out; a.ws = (unsigned char*)d_ws;
    a.ph_lo = 0; a.ph_hi = 13; a.li = 0;
    hipLaunchKernelGGL(mk_fwd, dim3(grid), dim3(NWAVES * 64), LDS_BYTES, stream, a);
}
```

```cpp
#include <hip/hip_runtime.h>
#include <cstdio>
#include <cstdint>
namespace pg8 {
#define PG8_LAS __attribute__((address_space(3)))
typedef unsigned short bf16_t;
typedef short bf16x8 __attribute__((ext_vector_type(8)));
typedef float f32x4 __attribute__((ext_vector_type(4)));
typedef unsigned u32x4 __attribute__((ext_vector_type(4)));
constexpr int BM = 256, BK = 64, HALF = 128, HTB = HALF * BK * 2  , STAGE_BYTES = 8 * HTB, NXCD = 8, WGM = 8;

__host__ __device__ __forceinline__ int lds_byte(int r, int c) { const int st = (r >> 4) * 2 + (c >> 5), rr = r & 15, cc = c & 31, ob = rr * 64 + cc * 2; return st * 1024 + (ob ^ (((ob >> 9) & 1) << 5)); }
__host__ __device__ __forceinline__ void stage_rc(int b, int& R, int& C) { const int st = b / 1024, sb = b % 1024, swz = sb ^ (((sb >> 9) & 1) << 5); R = (st >> 1) * 16 + swz / 64; C = (st & 1) * 32 + (swz % 64) / 2; }
__host__ __device__ __forceinline__ int perm32(int rho) { const int n = rho >> 4, i = rho & 15; return 8 * (i >> 2) + 4 * n + (i & 3); }

struct Unit { int pm, pn; };
struct Gemm { const bf16_t* A; const bf16_t* Bt; int M, N, K; };

struct StaticOrder {
    int nM, nN, nwg, G, c;
    __host__ __device__ void init(int M, int N, int G_, int c_) { nM = M / BM; nN = N / BM; nwg = nM * nN; G = G_; c = c_; }
    __host__ __device__ bool next(int i, Unit& u) const {
        const long L = (long)i * G + c; if (L >= nwg) return false;
        int wgid = (int)L; { const int q = nwg / NXCD, r = nwg % NXCD, xcd = wgid % NXCD, off = wgid / NXCD; wgid = (xcd < r ? xcd * (q + 1) : r * (q + 1) + (xcd - r) * q) + off; }
        const int nig = WGM * nN, gid = wgid / nig, fm = gid * WGM, gsz = (nM - fm) < WGM ? (nM - fm) : WGM;
        u.pm = fm + ((wgid % nig) % gsz); u.pn = (wgid % nig) / gsz; return true;
    }
    __device__ __forceinline__ void a_ready(const Unit&) const {}
    __device__ __forceinline__ void done(const Unit&) const {}
};

typedef float f32x2 __attribute__((ext_vector_type(2)));
typedef __bf16 bf16x2_t __attribute__((ext_vector_type(2)));
__device__ __forceinline__ unsigned cvt_pk_bf16(float lo, float hi) { const f32x2 v = {lo, hi}; const bf16x2_t b = __builtin_convertvector(v, bf16x2_t); return __builtin_bit_cast(unsigned, b); }
typedef unsigned u32x2 __attribute__((ext_vector_type(2)));
constexpr float RMS_EPS = 1e-6f, LOG2E = 1.4426950408889634f, QSCALE = 0.125f * 1.4426950408889634f;
__device__ __forceinline__ float bf_lo(unsigned w) { return __uint_as_float(w << 16); }
__device__ __forceinline__ float bf_hi(unsigned w) { return __uint_as_float(w & 0xffff0000u); }
__device__ __forceinline__ float fsigmoid(float x) { return __builtin_amdgcn_rcpf(1.f + __builtin_amdgcn_exp2f(-LOG2E * x)); }
__device__ __forceinline__ float fsig2(float xs) { return __builtin_amdgcn_rcpf(1.f + __builtin_amdgcn_exp2f(xs)); }
__device__ __forceinline__ u32x4 pack8(const f32x4 a, const f32x4 b) { u32x4 w; w.x = cvt_pk_bf16(a[0], a[1]); w.y = cvt_pk_bf16(a[2], a[3]); w.z = cvt_pk_bf16(b[0], b[1]); w.w = cvt_pk_bf16(b[2], b[3]); return w; }
__device__ __forceinline__ u32x2 pack4(const f32x4 a) { u32x2 w; w.x = cvt_pk_bf16(a[0], a[1]); w.y = cvt_pk_bf16(a[2], a[3]); return w; }
__device__ __forceinline__ void unpack8(const u32x4 w, f32x4& a, f32x4& b) { a = (f32x4){bf_lo(w.x), bf_hi(w.x), bf_lo(w.y), bf_hi(w.y)}; b = (f32x4){bf_lo(w.z), bf_hi(w.z), bf_lo(w.w), bf_hi(w.w)}; }
__device__ __forceinline__ f32x4 unpack4(const u32x2 w) { return (f32x4){bf_lo(w.x), bf_hi(w.x), bf_lo(w.y), bf_hi(w.y)}; }

template <int mode> struct EpiSwigluT { static constexpr bool PERM = true, AFTER_DRAIN = false;
    bf16_t* H;
    __device__ __forceinline__ void operator()(const f32x4 (&acc)[2][2][4][2], const Unit& u, int wr, int wc, int fr, int fq) const {
        const int row0 = u.pm * BM + wr * 64 + fr, col0 = u.pn * HALF + wc * 32 + 8 * fq;
        if (mode == 2) { f32x4 t = {0.f, 0.f, 0.f, 0.f};
#pragma unroll
            for (int ai = 0; ai < 2; ++ai)
#pragma unroll
                for (int bj = 0; bj < 2; ++bj)
#pragma unroll
                    for (int m = 0; m < 4; ++m) t += acc[ai][bj][m][0] + acc[ai][bj][m][1];
            if (t[0] + t[1] + t[2] + t[3] == 1.2345678e-30f) *(float*)(H + (size_t)row0 * 2816 + col0) = t[0];
            return; }
#pragma unroll
        for (int ai = 0; ai < 2; ++ai)
#pragma unroll
            for (int m = 0; m < 4; ++m) { const int row = row0 + ai * HALF + m * 16;
                f32x4 h0, h1;
#pragma unroll
                for (int j = 0; j < 4; ++j) { const float g0 = acc[ai][0][m][0][j], g1 = acc[ai][0][m][1][j]; h0[j] = g0 * fsig2(g0) * acc[ai][1][m][0][j]; h1[j] = g1 * fsig2(g1) * acc[ai][1][m][1][j]; }
                if (mode == 0) *(u32x4*)(H + (size_t)row * 2816 + col0) = pack8(h0, h1);
                else if (mode == 1) { const u32x4 w = pack8(h0, h1); if ((w.x ^ w.y ^ w.z ^ w.w) == 0x12345679u) *(u32x4*)(H + (size_t)row * 2816 + col0) = w; } }
    }
};
typedef EpiSwigluT<0> EpiSwiglu;
struct EpiRoute { static constexpr bool PERM = true, AFTER_DRAIN = false;
    bf16_t *AQ, *AKV, *MQK, *MV, *MO; float* GATES; const float* cs; const float* sn; const float* bgate;
    __device__ __forceinline__ void operator()(const f32x4 (&acc)[2][2][4][2], const Unit& u, int wr, int wc, int fr, int fq) const {
        const int pn = u.pn, row0 = u.pm * BM + wr * 64 + fr, cw = wc * 32 + 8 * fq;
        if (pn <= 2) {
            const bool rope_lane = (wc & 1) == 0 && fq < 2;
#pragma unroll
            for (int ai = 0; ai < 2; ++ai) {
                f32x4 cc[4], ss[4];
#pragma unroll
                for (int m = 0; m < 4; ++m) { const int s = (row0 + ai * HALF + m * 16) & 4095; cc[m] = (f32x4){1.f, 1.f, 1.f, 1.f}; ss[m] = (f32x4){0.f, 0.f, 0.f, 0.f};
                    if (rope_lane) { cc[m] = *(const f32x4*)(cs + s * 8 + 4 * fq); ss[m] = *(const f32x4*)(sn + s * 8 + 4 * fq); } }
                asm volatile("" ::: "memory");
#pragma unroll
                for (int m = 0; m < 4; ++m) { const int row = row0 + ai * HALF + m * 16; const float r = (pn < 2 ? QSCALE : 1.0f);
#pragma unroll
                    for (int bj = 0; bj < 2; ++bj) { const f32x4 v0 = acc[ai][bj][m][0] * r, v1 = acc[ai][bj][m][1] * r; const int tc = bj * HALF + cw;
                        bf16_t* dst = (pn < 2) ? AQ + (size_t)row * 512 + pn * 256 + tc : AKV + (size_t)row * 256 + tc;
                        if (rope_lane && !(pn == 2 && bj == 1)) {
                            const f32x4 r1 = v0 * cc[m] - v1 * ss[m], r2 = v1 * cc[m] + v0 * ss[m];
                            dst -= 8 * fq;
                            *(u32x2*)(dst + 4 * fq) = pack4(r1); *(u32x2*)(dst + 8 + 4 * fq) = pack4(r2);
                        } else *(u32x4*)dst = pack8(v0, v1); } }
                asm volatile("" ::: "memory"); }
        } else if (pn <= 14) {
            bf16_t* base = (pn <= 6) ? MQK + (pn - 3) * 256 : (pn <= 10) ? MV + (pn - 7) * 256 : MO + (pn - 11) * 256; const bool sg = pn > 10;
#pragma unroll
            for (int ai = 0; ai < 2; ++ai)
#pragma unroll
                for (int m = 0; m < 4; ++m) { const int row = row0 + ai * HALF + m * 16;
#pragma unroll
                    for (int bj = 0; bj < 2; ++bj) { f32x4 v0 = acc[ai][bj][m][0], v1 = acc[ai][bj][m][1];
                        if (sg) {
#pragma unroll
                            for (int j = 0; j < 4; ++j) { v0[j] = fsig2(v0[j]); v1[j] = fsig2(v1[j]); } }
                        *(u32x4*)(base + (size_t)row * 1024 + bj * HALF + cw) = pack8(v0, v1); } }
        } else if (wc == 0 && fq < 2) {
            const f32x4 b0 = *(const f32x4*)(bgate + 8 * fq), b1 = *(const f32x4*)(bgate + 8 * fq + 4);
#pragma unroll
            for (int ai = 0; ai < 2; ++ai)
#pragma unroll
                for (int m = 0; m < 4; ++m) { const int row = row0 + ai * HALF + m * 16;
                    const f32x4 li = acc[ai][0][m][0] + b0; f32x4 lf = acc[ai][0][m][1] + b1;
#pragma unroll
                    for (int j = 0; j < 4; ++j) lf[j] = fminf(lf[j], 0.f) - log1pf(expf(-fabsf(lf[j])));
                    *(f32x4*)(GATES + (size_t)row * 16 + 8 * fq) = li; *(f32x4*)(GATES + (size_t)row * 16 + 8 * fq + 4) = lf; }
        }
    }
};
struct EpiSig { static constexpr bool PERM = true, AFTER_DRAIN = false;
    bf16_t *BGA, *BGM;
    __device__ __forceinline__ void operator()(const f32x4 (&acc)[2][2][4][2], const Unit& u, int wr, int wc, int fr, int fq) const {
        const int row0 = u.pm * BM + wr * 64 + fr, cw = wc * 32 + 8 * fq; bf16_t* base = (u.pn < 4) ? BGA + u.pn * 256 : BGM + (u.pn - 4) * 256;
#pragma unroll
        for (int ai = 0; ai < 2; ++ai)
#pragma unroll
            for (int m = 0; m < 4; ++m) { const int row = row0 + ai * HALF + m * 16;
#pragma unroll
                for (int bj = 0; bj < 2; ++bj) { f32x4 v0 = acc[ai][bj][m][0], v1 = acc[ai][bj][m][1];
#pragma unroll
                    for (int j = 0; j < 4; ++j) { v0[j] = fsig2(v0[j]); v1[j] = fsig2(v1[j]); }
                    *(u32x4*)(base + (size_t)row * 1024 + bj * HALF + cw) = pack8(v0, v1); } }
    }
};
template <bool ADD> struct EpiMul { static constexpr bool PERM = true, AFTER_DRAIN = false;
    bf16_t* O; const bf16_t* G; const bf16_t* T;
    __device__ __forceinline__ void operator()(const f32x4 (&acc)[2][2][4][2], const Unit& u, int wr, int wc, int fr, int fq) const {
        const int row0 = u.pm * BM + wr * 64 + fr, col0 = u.pn * BM + wc * 32 + 8 * fq;
#pragma unroll
        for (int ai = 0; ai < 2; ++ai) {
            u32x4 gq[4][2], tq[4][2];
#pragma unroll
            for (int m = 0; m < 4; ++m)
#pragma unroll
                for (int bj = 0; bj < 2; ++bj) { const size_t ro = (size_t)(row0 + ai * HALF + m * 16) * 1024 + col0 + bj * HALF; gq[m][bj] = __builtin_nontemporal_load((const u32x4*)(G + ro)); if (ADD) tq[m][bj] = __builtin_nontemporal_load((const u32x4*)(T + ro)); }
            asm volatile("" ::: "memory");
#pragma unroll
            for (int m = 0; m < 4; ++m)
#pragma unroll
                for (int bj = 0; bj < 2; ++bj) { f32x4 g0, g1; unpack8(gq[m][bj], g0, g1); f32x4 v0 = acc[ai][bj][m][0] * g0, v1 = acc[ai][bj][m][1] * g1;
                    if (ADD) { f32x4 t0, t1; unpack8(tq[m][bj], t0, t1); v0 = v0 + t0; v1 = v1 + t1; }
                    gq[m][bj] = pack8(v0, v1); }
#pragma unroll
            for (int m = 0; m < 4; ++m)
#pragma unroll
                for (int bj = 0; bj < 2; ++bj) *(u32x4*)(O + (size_t)(row0 + ai * HALF + m * 16) * 1024 + col0 + bj * HALF) = gq[m][bj];
            asm volatile("" ::: "memory"); }
    }
};
struct EpiPlainNP { static constexpr bool PERM = true, AFTER_DRAIN = false;
    bf16_t* O;
    __device__ __forceinline__ void operator()(const f32x4 (&acc)[2][2][4][2], const Unit& u, int wr, int wc, int fr, int fq) const {
        const int row0 = u.pm * BM + wr * 64 + fr, col0 = u.pn * BM + wc * 32 + 8 * fq;
#pragma unroll
        for (int ai = 0; ai < 2; ++ai)
#pragma unroll
            for (int m = 0; m < 4; ++m) { const size_t ro = (size_t)(row0 + ai * HALF + m * 16) * 1024 + col0;
#pragma unroll
                for (int bj = 0; bj < 2; ++bj) *(u32x4*)(O + ro + bj * HALF) = pack8(acc[ai][bj][m][0], acc[ai][bj][m][1]); }
    }
};
struct PanelSsq {
    unsigned* xbuf;
    unsigned* cnt;
    unsigned* tmo; unsigned code;
    __device__ __forceinline__ static void partials(const f32x4 (&v)[2][2][4][2], int wr, int wc, int fr, int fq, PG8_LAS float* P) {
#pragma unroll
        for (int ai = 0; ai < 2; ++ai)
#pragma unroll
            for (int m = 0; m < 4; ++m) { float s = 0.f;
#pragma unroll
                for (int bj = 0; bj < 2; ++bj)
#pragma unroll
                    for (int n = 0; n < 2; ++n) { const f32x4 x = v[ai][bj][m][n]; s += (x[0] * x[0] + x[1] * x[1]) + (x[2] * x[2] + x[3] * x[3]); }
                s += __shfl_xor(s, 16); s += __shfl_xor(s, 32);
                if (fq == 0) P[(ai * HALF + wr * 64 + m * 16 + fr) * 4 + wc] = s; }
    }
    __device__ __forceinline__ bool run(const f32x4 (&v)[2][2][4][2], const Unit& u, int wr, int wc, int fr, int fq, PG8_LAS unsigned char* lds, int wid, int lane) const {
        PG8_LAS float* P = (PG8_LAS float*)lds;
        PG8_LAS float* S = (PG8_LAS float*)(lds + 8192);
        PG8_LAS unsigned* flag = (PG8_LAS unsigned*)(lds + 8192 + 2048);
        partials(v, wr, wc, fr, fq, P);
        if (wid == 0 && lane == 0) flag[0] = 0u;
        asm volatile("s_waitcnt lgkmcnt(0)" ::: "memory"); __builtin_amdgcn_s_barrier(); asm volatile("" ::: "memory");
        const int row = wid * 32 + (lane & 31);
        if (lane < 32) { const float t = (P[row * 4 + 0] + P[row * 4 + 1]) + (P[row * 4 + 2] + P[row * 4 + 3]);
            unsigned* slot = xbuf + (size_t)(u.pm * BM + row) * 4;
            __hip_atomic_store(slot + u.pn, __float_as_uint(t) | 1u, __ATOMIC_RELAXED, __HIP_MEMORY_SCOPE_AGENT);
            unsigned a0, a1, a2, a3; bool okk; int it = 0;
            do {
                a0 = __hip_atomic_load(slot + 0, __ATOMIC_RELAXED, __HIP_MEMORY_SCOPE_AGENT); a1 = __hip_atomic_load(slot + 1, __ATOMIC_RELAXED, __HIP_MEMORY_SCOPE_AGENT);
                a2 = __hip_atomic_load(slot + 2, __ATOMIC_RELAXED, __HIP_MEMORY_SCOPE_AGENT); a3 = __hip_atomic_load(slot + 3, __ATOMIC_RELAXED, __HIP_MEMORY_SCOPE_AGENT);
                okk = (a0 != 0u) & (a1 != 0u) & (a2 != 0u) & (a3 != 0u);
                if (__all(okk)) break;
                __builtin_amdgcn_s_sleep(1);
            } while (++it < 40000);
            const bool dead = !okk;
            if (dead) { __hip_atomic_store(tmo + 1, code | (unsigned)(u.pm & 0xff), __ATOMIC_RELAXED, __HIP_MEMORY_SCOPE_AGENT); __hip_atomic_store(tmo, 1u, __ATOMIC_RELAXED, __HIP_MEMORY_SCOPE_AGENT); flag[0] = 1u; }
            const float tt = (__uint_as_float(a0) + __uint_as_float(a1)) + (__uint_as_float(a2) + __uint_as_float(a3));
            S[row] = rsqrtf(tt * (1.f / 1024.f) + RMS_EPS); }
        asm volatile("s_waitcnt vmcnt(0) lgkmcnt(0)" ::: "memory"); __builtin_amdgcn_s_barrier(); asm volatile("" ::: "memory");
        const bool bad = flag[0] != 0u;
        return bad;
    }
};
struct EpiRmsRes { static constexpr bool PERM = true, AFTER_DRAIN = true;
    bf16_t* xn; const float* inv_prev; float* inv_new; const float* gpost; float scale; PanelSsq st, st2; unsigned poison;
    __device__ __forceinline__ void fused(f32x4 (&acc)[2][2][4][2], const Unit& u, int wr, int wc, int fr, int fq, PG8_LAS unsigned char* lds, int wid, int lane) const {
        const PG8_LAS float* S = (const PG8_LAS float*)(lds + 8192);
        const int col0 = u.pn * BM + wc * 32 + 8 * fq, row0 = u.pm * BM + wr * 64 + fr;
        const float sc_ = scale;
        u32x4 pre[4][2]; float iv[2][4];
#pragma unroll
        for (int m = 0; m < 4; ++m)
#pragma unroll
            for (int bj = 0; bj < 2; ++bj) pre[m][bj] = __builtin_nontemporal_load((const u32x4*)(xn + (size_t)(row0 + m * 16) * 1024 + col0 + bj * HALF));
        const bool bad = st.run(acc, u, wr, wc, fr, fq, lds, wid, lane) || poison != 0u;
        int row1 = row0, col1 = col0; asm volatile("" : "+v"(row1), "+v"(col1));
#pragma unroll
        for (int ai = 0; ai < 2; ++ai)
#pragma unroll
            for (int m = 0; m < 4; ++m) iv[ai][m] = inv_prev[row1 + ai * HALF + m * 16];
        f32x4 gp[2][2];
#pragma unroll
        for (int bj = 0; bj < 2; ++bj)
#pragma unroll
            for (int n = 0; n < 2; ++n) { const f32x4 g4 = *(const f32x4*)(gpost + col1 + bj * HALF + 4 * n); gp[bj][n] = (f32x4){g4[0] * sc_, g4[1] * sc_, g4[2] * sc_, g4[3] * sc_}; }
#pragma unroll
        for (int ai = 0; ai < 2; ++ai) {
#pragma unroll
            for (int m = 0; m < 4; ++m) { const float sr = S[ai * HALF + wr * 64 + m * 16 + fr], ivr = iv[ai][m];
#pragma unroll
                for (int bj = 0; bj < 2; ++bj) { f32x4 b0, b1; unpack8(pre[m][bj], b0, b1);
                    acc[ai][bj][m][0] = b0 * ivr + acc[ai][bj][m][0] * sr * gp[bj][0]; acc[ai][bj][m][1] = b1 * ivr + acc[ai][bj][m][1] * sr * gp[bj][1]; } }
            if (ai == 0) {
#pragma unroll
                for (int m = 0; m < 4; ++m)
#pragma unroll
                    for (int bj = 0; bj < 2; ++bj) pre[m][bj] = __builtin_nontemporal_load((const u32x4*)(xn + (size_t)(row1 + HALF + m * 16) * 1024 + col1 + bj * HALF));
            }
        }
        const bool bad2 = st2.run(acc, u, wr, wc, fr, fq, lds, wid, lane) || bad;
#pragma unroll
        for (int ai = 0; ai < 2; ++ai)
#pragma unroll
            for (int m = 0; m < 4; ++m) { const float sr = S[ai * HALF + wr * 64 + m * 16 + fr]; const size_t off = (size_t)(row1 + ai * HALF + m * 16) * 1024 + col1;
#pragma unroll
                for (int bj = 0; bj < 2; ++bj) { u32x4 w = pack8(acc[ai][bj][m][0] * sr, acc[ai][bj][m][1] * sr); if (bad2) w = (u32x4){0x7fc07fc0u, 0x7fc07fc0u, 0x7fc07fc0u, 0x7fc07fc0u}; *(u32x4*)(xn + off + bj * HALF) = w; } }
        if (u.pn == 0 && lane < 32) { const int row = wid * 32 + lane; inv_new[u.pm * BM + row] = 1.0f / S[row]; }
    }
};
struct EpiPle { static constexpr bool PERM = true, AFTER_DRAIN = true;
    const bf16_t* xn; const float* inv_prev; float* out; const bf16_t* PR; const float* gpost; PanelSsq st; unsigned poison;
    __device__ __forceinline__ void fused(f32x4 (&acc)[2][2][4][2], const Unit& u, int wr, int wc, int fr, int fq, PG8_LAS unsigned char* lds, int wid, int lane) const {
        const PG8_LAS float* S = (const PG8_LAS float*)(lds + 8192);
        const int col0 = u.pn * BM + wc * 32 + 8 * fq, row0 = u.pm * BM + wr * 64 + fr;
#pragma unroll
        for (int ai = 0; ai < 2; ++ai) {
            u32x4 prq[4][2];
#pragma unroll
            for (int m = 0; m < 4; ++m)
#pragma unroll
                for (int bj = 0; bj < 2; ++bj) prq[m][bj] = __builtin_nontemporal_load((const u32x4*)(PR + (size_t)(row0 + ai * HALF + m * 16) * 1024 + col0 + bj * HALF));
            asm volatile("" ::: "memory");
#pragma unroll
            for (int m = 0; m < 4; ++m)
#pragma unroll
                for (int bj = 0; bj < 2; ++bj) { f32x4 p0, p1; unpack8(prq[m][bj], p0, p1); f32x4 a0 = acc[ai][bj][m][0], a1 = acc[ai][bj][m][1];
#pragma unroll
                    for (int j = 0; j < 4; ++j) { a0[j] = fsig2(a0[j]); a1[j] = fsig2(a1[j]); }
                    acc[ai][bj][m][0] = p0 * a0; acc[ai][bj][m][1] = p1 * a1; }
            asm volatile("" ::: "memory"); }
        const bool bad = st.run(acc, u, wr, wc, fr, fq, lds, wid, lane) || poison != 0u;
        asm volatile("" ::: "memory");
        const float qnan = __builtin_nanf("");
        f32x4 gp[2][2];
#pragma unroll
        for (int bj = 0; bj < 2; ++bj)
#pragma unroll
            for (int n = 0; n < 2; ++n) gp[bj][n] = *(const f32x4*)(gpost + col0 + bj * HALF + 4 * n);
#pragma unroll
        for (int ai = 0; ai < 2; ++ai)
#pragma unroll
            for (int mp = 0; mp < 2; ++mp) {
                u32x4 pre[2][2]; float iv[2];
#pragma unroll
                for (int mm = 0; mm < 2; ++mm) { const int m = 2 * mp + mm; iv[mm] = inv_prev[row0 + ai * HALF + m * 16];
#pragma unroll
                    for (int bj = 0; bj < 2; ++bj) pre[mm][bj] = *(const u32x4*)(xn + (size_t)(row0 + ai * HALF + m * 16) * 1024 + col0 + bj * HALF); }
                asm volatile("" ::: "memory");
#pragma unroll
                for (int mm = 0; mm < 2; ++mm) { const int m = 2 * mp + mm; const float sr = S[ai * HALF + wr * 64 + m * 16 + fr]; const size_t off = (size_t)(row0 + ai * HALF + m * 16) * 1024 + col0;
#pragma unroll
                    for (int bj = 0; bj < 2; ++bj) { f32x4 b0, b1; unpack8(pre[mm][bj], b0, b1);
                        f32x4 o0 = b0 * iv[mm] + acc[ai][bj][m][0] * sr * gp[bj][0], o1 = b1 * iv[mm] + acc[ai][bj][m][1] * sr * gp[bj][1];
                        if (bad) { o0 = (f32x4){qnan, qnan, qnan, qnan}; o1 = o0; }
                        *(f32x4*)(out + off + bj * HALF) = o0; *(f32x4*)(out + off + bj * HALF + 4) = o1; } }
                asm volatile("" ::: "memory"); }
    }
};
struct QueueOrder { StaticOrder so; unsigned* ctr; int limit; PG8_LAS int* slot; int wave, xlab;
    __device__ __forceinline__ bool next(int i, Unit& u) const {
        if (wave == 0) { int v = 0; int l_; asm volatile("v_mbcnt_lo_u32_b32 %0, -1, 0\n\tv_mbcnt_hi_u32_b32 %0, -1, %0" : "=v"(l_));
            if (l_ == 0) v = (int)__hip_atomic_fetch_add(ctr, 1u, __ATOMIC_RELAXED, __HIP_MEMORY_SCOPE_AGENT);
            v = __builtin_amdgcn_readfirstlane(v); if (l_ == 0) slot[i & 1] = v; }
        asm volatile("s_waitcnt vmcnt(0) lgkmcnt(0)" ::: "memory"); __builtin_amdgcn_s_barrier(); asm volatile("" ::: "memory");
        const int tk = __builtin_amdgcn_readfirstlane(slot[i & 1]);
        const int L = NXCD * tk + xlab;
        if (L >= limit) return false; StaticOrder t = so; t.G = 1; t.c = 0; return t.next(L, u); }
    __device__ __forceinline__ void a_ready(const Unit&) const {}
    __device__ __forceinline__ void done(const Unit&) const {}
};
struct RoundOrder { StaticOrder so; int round;
    __device__ __forceinline__ bool next(int i, Unit& u) const { return i == 0 && so.next(round, u); }
    __device__ __forceinline__ void a_ready(const Unit&) const {}
    __device__ __forceinline__ void done(const Unit&) const {}
};
__device__ __forceinline__ void zero4(f32x4& v) {
    typedef unsigned long long u64x2_ __attribute__((ext_vector_type(2)));
    unsigned long long lo, hi;
    asm volatile("v_mov_b64 %0, 0" : "=v"(lo)); asm volatile("v_mov_b64 %0, 0" : "=v"(hi));
    const u64x2_ z = {lo, hi}; v = __builtin_bit_cast(f32x4, z);
}
template <int KK, class Epi, class Sched, bool ALIGN_EPI = false, bool SP2 = false, bool ABLK = false>
__device__ __forceinline__ void gemm_phase(PG8_LAS unsigned char* lds, const Gemm g, const Sched& S, const Epi& E, const int wave_s) {
    int tid_; asm volatile("v_mbcnt_lo_u32_b32 %0, -1, 0\n\tv_mbcnt_hi_u32_b32 %0, -1, %0" : "=v"(tid_)); tid_ += wave_s * 64;
    const int tid = tid_, wid = wave_s, lane = tid & 63, wr = wid >> 2, wc = wid & 3, fr = lane & 15, fq = lane >> 4;
    constexpr int K = KK, nt = K / BK;
    unsigned voffA[2], voffB[2];
#pragma unroll
    for (int i = 0; i < 2; ++i) { int R, C; stage_rc(tid * 16 + i * 8192, R, C); const int Rb = Epi::PERM ? ((R & ~31) + perm32(R & 31)) : R;
        voffA[i] = ABLK ? (unsigned)(((R >> 1) * (K / 32) + (C >> 5)) * 128 + (R & 1) * 64 + (C & 31) * 2) : (unsigned)(R * K + C) * 2u; voffB[i] = (unsigned)(Rb * K + C) * 2u; }
    const size_t kstep = (size_t)(BK * 2);
    const size_t kstepA = ABLK ? (size_t)256 : kstep;
    const size_t hstep = (size_t)HALF * K * 2;
    const size_t tstep = 2 * hstep;
    const unsigned ldsw = (unsigned)wid * 1024u;
    const int aoff = lds_byte(wr * 64 + fr, fq * 8), boff = lds_byte(wc * 32 + fr, fq * 8);
#define PG8_SA(b, h) (((b) * 2 + (h)) * HTB)
#define PG8_SB(b, h) ((4 + (b) * 2 + (h)) * HTB)
#define PG8_STAGE(bufoff, gbase, voff) do { _Pragma("unroll") for (int _i = 0; _i < 2; ++_i) \
        __builtin_amdgcn_global_load_lds((const unsigned*)((const char*)(gbase) + (voff)[_i]), (PG8_LAS unsigned*)(lds + (bufoff) + ldsw + _i * 8192), 16, 0, 0); } while (0)
#define PG8_LDA(dst, b, h) do { _Pragma("unroll") for (int m = 0; m < 4; ++m) _Pragma("unroll") for (int k = 0; k < 2; ++k) dst[m][k] = *(const PG8_LAS bf16x8*)(lds + PG8_SA(b, h) + aoff + m * 2048 + k * 1024); } while (0)
#define PG8_LDB(dst, b, h) do { _Pragma("unroll") for (int n = 0; n < 2; ++n) _Pragma("unroll") for (int k = 0; k < 2; ++k) dst[n][k] = *(const PG8_LAS bf16x8*)(lds + PG8_SB(b, h) + boff + n * 2048 + k * 1024); } while (0)
#define PG8_MMA(ai, bj, At, Bt) do { __builtin_amdgcn_s_setprio(1); _Pragma("unroll") for (int m = 0; m < 4; ++m) _Pragma("unroll") for (int n = 0; n < 2; ++n) _Pragma("unroll") for (int k = 0; k < 2; ++k) \
        acc[ai][bj][m][n] = __builtin_amdgcn_mfma_f32_16x16x32_bf16(Bt[n][k], At[m][k], acc[ai][bj][m][n], 0, 0, 0); __builtin_amdgcn_s_setprio(0); } while (0)
#define PG8_WAIT_V(n) asm volatile("s_waitcnt vmcnt(" #n ")" ::: "memory")
#define PG8_WAIT_L(n) asm volatile("s_waitcnt lgkmcnt(" #n ")" ::: "memory")
#define PG8_BAR __builtin_amdgcn_s_barrier()
#define PG8_SCHED __builtin_amdgcn_sched_barrier(0)
    Unit cur, nxt; int ui = 0;
    if (!S.next(0, cur)) return;
    f32x4 acc[2][2][4][2];
#pragma unroll
    for (int a = 0; a < 2; ++a)
#pragma unroll
        for (int b = 0; b < 2; ++b)
#pragma unroll
            for (int m = 0; m < 4; ++m)
#pragma unroll
                for (int n = 0; n < 2; ++n) acc[a][b][m][n] = (f32x4){0.f, 0.f, 0.f, 0.f};
    bf16x8 At[4][2], B0[2][2], B1[2][2];
    const char* cA = (const char*)g.A + (size_t)cur.pm * tstep; const char* cB = (const char*)g.Bt + (size_t)cur.pn * tstep;
    S.a_ready(cur);
    if constexpr (SP2) {
        PG8_STAGE(PG8_SB(0, 0), cB, voffB); PG8_STAGE(PG8_SB(0, 1), cB + hstep, voffB); PG8_STAGE(PG8_SA(0, 0), cA, voffA); PG8_STAGE(PG8_SA(0, 1), cA + hstep, voffA);
        if (wr == 1) PG8_BAR;
        PG8_WAIT_V(2); PG8_BAR;
        PG8_STAGE(PG8_SB(1, 0), cB + kstep, voffB); PG8_STAGE(PG8_SA(1, 0), cA + kstepA, voffA); PG8_STAGE(PG8_SB(1, 1), cB + hstep + kstep, voffB);
        PG8_WAIT_V(6); PG8_BAR;
    } else {
        PG8_STAGE(PG8_SB(0, 0), cB, voffB); PG8_STAGE(PG8_SA(0, 0), cA, voffA); PG8_STAGE(PG8_SB(0, 1), cB + hstep, voffB); PG8_STAGE(PG8_SA(0, 1), cA + hstep, voffA);
        if (wr == 1) PG8_BAR;
        PG8_WAIT_V(4); PG8_BAR;
        PG8_STAGE(PG8_SB(1, 0), cB + kstep, voffB); PG8_STAGE(PG8_SA(1, 0), cA + kstepA, voffA); PG8_STAGE(PG8_SB(1, 1), cB + hstep + kstep, voffB);
        PG8_WAIT_V(6); PG8_BAR;
    }
    for (;;) {
        const bool has_next = S.next(ui + 1, nxt);
        const char* nA = has_next ? (const char*)g.A + (size_t)nxt.pm * tstep : cA; const char* nB = has_next ? (const char*)g.Bt + (size_t)nxt.pn * tstep : cB;
#pragma nounroll
        for (int t = 0; t < nt; t += 2) {
            const bool last = (t == nt - 2);
            const char* a1 = cA + (size_t)(t + 1) * kstepA;
            const char* a2 = last ? nA : cA + (size_t)(t + 2) * kstepA; const char* b2 = last ? nB : cB + (size_t)(t + 2) * kstep;
            const char* a3 = a2 + kstepA; const char* b3 = b2 + kstep;
            if (last && has_next) S.a_ready(nxt);
            if constexpr (SP2) {
            PG8_LDB(B0, 0, 0); PG8_LDB(B1, 0, 1); PG8_SCHED; PG8_LDA(At, 0, 0); PG8_STAGE(PG8_SA(1, 1), a1 + hstep, voffA);
            PG8_WAIT_V(8); PG8_WAIT_L(0); PG8_BAR; PG8_MMA(0, 0, At, B0); PG8_MMA(0, 1, At, B1); PG8_BAR; PG8_SCHED;
            PG8_LDA(At, 0, 1); PG8_STAGE(PG8_SB(0, 0), b2, voffB); PG8_STAGE(PG8_SB(0, 1), b2 + hstep, voffB); PG8_STAGE(PG8_SA(0, 0), a2, voffA);
            PG8_WAIT_V(8); PG8_WAIT_L(0); PG8_BAR; PG8_MMA(1, 0, At, B0); PG8_MMA(1, 1, At, B1); PG8_BAR; PG8_SCHED;
            PG8_LDB(B0, 1, 0); PG8_LDB(B1, 1, 1); PG8_SCHED; PG8_LDA(At, 1, 0); PG8_STAGE(PG8_SA(0, 1), a2 + hstep, voffA);
            PG8_WAIT_V(8); PG8_WAIT_L(0); PG8_BAR; PG8_MMA(0, 0, At, B0); PG8_MMA(0, 1, At, B1); PG8_BAR; PG8_SCHED;
            PG8_LDA(At, 1, 1); PG8_STAGE(PG8_SB(1, 0), b3, voffB); PG8_STAGE(PG8_SB(1, 1), b3 + hstep, voffB); PG8_STAGE(PG8_SA(1, 0), a3, voffA);
            PG8_WAIT_V(8); PG8_WAIT_L(0); PG8_BAR; PG8_MMA(1, 0, At, B0); PG8_MMA(1, 1, At, B1); PG8_BAR; PG8_SCHED;
            } else {
            PG8_LDB(B0, 0, 0); PG8_SCHED; PG8_LDA(At, 0, 0); PG8_STAGE(PG8_SA(1, 1), a1 + hstep, voffA);
            PG8_WAIT_L(8); PG8_BAR; PG8_WAIT_L(0); PG8_MMA(0, 0, At, B0); PG8_BAR; PG8_SCHED;
            PG8_LDB(B1, 0, 1); PG8_STAGE(PG8_SB(0, 0), b2, voffB);
            PG8_BAR; PG8_WAIT_L(0); PG8_MMA(0, 1, At, B1); PG8_BAR;
            PG8_LDA(At, 0, 1); PG8_STAGE(PG8_SA(0, 0), a2, voffA);
            PG8_BAR; PG8_WAIT_L(0); PG8_MMA(1, 0, At, B0); PG8_BAR; PG8_SCHED;
            PG8_STAGE(PG8_SB(0, 1), b2 + hstep, voffB);
            PG8_WAIT_V(6); PG8_BAR; PG8_MMA(1, 1, At, B1); PG8_BAR;
            PG8_LDB(B0, 1, 0); PG8_SCHED; PG8_LDA(At, 1, 0); PG8_STAGE(PG8_SA(0, 1), a2 + hstep, voffA);
            PG8_WAIT_L(8); PG8_BAR; PG8_WAIT_L(0); PG8_MMA(0, 0, At, B0); PG8_BAR; PG8_SCHED;
            PG8_LDB(B1, 1, 1); PG8_STAGE(PG8_SB(1, 0), b3, voffB);
            PG8_BAR; PG8_WAIT_L(0); PG8_MMA(0, 1, At, B1); PG8_BAR;
            PG8_LDA(At, 1, 1); PG8_STAGE(PG8_SA(1, 0), a3, voffA);
            PG8_BAR; PG8_WAIT_L(0); PG8_MMA(1, 0, At, B0); PG8_BAR; PG8_SCHED;
            PG8_STAGE(PG8_SB(1, 1), b3 + hstep, voffB);
            PG8_WAIT_V(6); PG8_BAR; PG8_MMA(1, 1, At, B1); PG8_BAR;
            }
        }
        if constexpr (ALIGN_EPI) { if (wr == 0) PG8_BAR; }
        if constexpr (!Epi::AFTER_DRAIN) { int fr_ = fr, fq_ = fq; asm volatile("" : "+v"(fr_), "+v"(fq_));
            E(acc, cur, wr, wc, fr_, fq_); S.done(cur); }
        if (!has_next) break;
#pragma unroll
        for (int a = 0; a < 2; ++a)
#pragma unroll
            for (int b = 0; b < 2; ++b)
#pragma unroll
                for (int m = 0; m < 4; ++m)
#pragma unroll
                    for (int n = 0; n < 2; ++n) zero4(acc[a][b][m][n]);
        cur = nxt; cA = nA; cB = nB; ++ui;
        if constexpr (ALIGN_EPI) { if (wr == 1) PG8_BAR; }
    }
    PG8_WAIT_V(0);
    if constexpr (!ALIGN_EPI) { if (wr == 0) PG8_BAR; }
    PG8_BAR;
    if constexpr (Epi::AFTER_DRAIN) { int fr_ = fr, fq_ = fq, lane_ = lane; asm volatile("" : "+v"(fr_), "+v"(fq_), "+v"(lane_)); E.fused(acc, cur, wr, wc, fr_, fq_, lds, wid, lane_); S.done(cur); }
#undef PG8_SA
#undef PG8_SB
#undef PG8_STAGE
#undef PG8_LDA
#undef PG8_LDB
#undef PG8_MMA
#undef PG8_WAIT_V
#undef PG8_WAIT_L
#undef PG8_BAR
#undef PG8_SCHED
}
}
constexpr int NWAVES = 8;
constexpr int BATCH = 8, SEQ = 4096, DM = 1024, PLE_DIM = 256, FFN = 2816, M = BATCH * SEQ;
constexpr int INW = 5904;
constexpr size_t MiB = 1u << 20;
constexpr size_t WS_CTL = 0, CTL_ZERO_BYTES = 1 * MiB;
constexpr size_t WS_W1A = 2 * MiB, WS_W2A = WS_W1A + 11 * MiB, WS_WINA = WS_W2A + 11 * MiB / 2, WS_WINB = WS_WINA + 8 * MiB, WS_WBA = WS_WINB + 4 * MiB, WS_WBM = WS_WBA + 1 * MiB,
                 WS_WOUT = WS_WBM + 2 * MiB, WS_W1B = WS_WOUT + 2 * MiB, WS_W2B = WS_W1B + 11 * MiB, WS_WPG = WS_W2B + 11 * MiB / 2, WS_WPP = WS_WPG + 2 * MiB, WS_WEND = WS_WPP + MiB / 2;
static_assert(WS_WEND <= 55 * MiB, "weights");
constexpr size_t WS_ROPE = 55 * MiB;
constexpr size_t WS_SSQ = 56 * MiB;
constexpr size_t WS_GATES = 58 * MiB;
constexpr size_t WS_XBUF = 60 * MiB;
constexpr size_t WS_XN = 64 * MiB;
constexpr size_t WS_AQ = 128 * MiB, WS_AKV = 160 * MiB, WS_MQK = 176 * MiB, WS_MV = 240 * MiB, WS_MO = 304 * MiB, WS_CQK = 368 * MiB, WS_HSF = 176 * MiB, WS_HSB = 432 * MiB, WS_HM = 304 * MiB;
constexpr size_t WS_BGA = 240 * MiB, WS_BGM = 176 * MiB, WS_T1 = 432 * MiB, WS_MG = 368 * MiB, WS_H = 128 * MiB, WS_PR = 304 * MiB, WS_PB = 496 * MiB, WS_END = 512 * MiB;
constexpr int CW_TMO = 0, CW_CODE = 1;
constexpr int CW_HMG = 2048;
constexpr int CW_G3BQ = 1024;
constexpr int CW_BAR = 4096;
constexpr int CW_SEAM = 32768, SEAM_BANK = 128 * 64;
static_assert((CW_SEAM + 7 * SEAM_BANK) * 4 <= (int)CTL_ZERO_BYTES, "CTL words inside the memset region");
constexpr int RING_OFF = 0, RING_BYTES = 131072;
constexpr int LDS_BYTES = 163840;
constexpr int LDSCTL_OFF = LDS_BYTES - 512, MISC_OFF = LDSCTL_OFF + 320;
#define GAS __attribute__((address_space(1)))
#define LAS __attribute__((address_space(3)))
typedef unsigned short bf16;
typedef unsigned v4u __attribute__((ext_vector_type(4)));
typedef float f32x4 __attribute__((ext_vector_type(4)));
typedef short bf16x8 __attribute__((ext_vector_type(8)));
typedef GAS unsigned gu32;
typedef GAS unsigned long long gu64;
#define RLX_AGENT __ATOMIC_RELAXED, __HIP_MEMORY_SCOPE_AGENT
#define LDS_WAIT() asm volatile("s_waitcnt lgkmcnt(0)" ::: "memory")
#define VM_WAIT() asm volatile("s_waitcnt vmcnt(0)" ::: "memory")
__device__ __forceinline__ unsigned long long rt() { return __builtin_amdgcn_s_memrealtime(); }
__device__ __forceinline__ unsigned f2bf(float f) { unsigned u = __builtin_bit_cast(unsigned, f); return (u + 0x7fffu + ((u >> 16) & 1u)) >> 16; }
__device__ __forceinline__ unsigned pk2(float lo, float hi) { return pg8::cvt_pk_bf16(lo, hi); }

#define XB_TMO      128
#define XB_XCNT(j)  (256  + 64 * (j))
#define XB_XSUB(j)  (1280 + 64 * (j))
#define XB_XGEN(j)  (2304 + 64 * (j))
#define XB_TOP      3328
#define XB_TOPGEN   3392
#define XCD_BAR_WORDS 3456
#define XB_SPIN_CAP (1u << 18)

__device__ __forceinline__ unsigned xb_ld(unsigned* p)              { return __hip_atomic_load(p, __ATOMIC_RELAXED, __HIP_MEMORY_SCOPE_AGENT); }
__device__ __forceinline__ unsigned xb_add(unsigned* p, unsigned v) { return __hip_atomic_fetch_add(p, v, __ATOMIC_RELAXED, __HIP_MEMORY_SCOPE_AGENT); }
__device__ __forceinline__ unsigned xb_xcc_id() { return (unsigned)__builtin_amdgcn_s_getreg((3 << 11) | 20) & 0xFu; }
#define XB_SPIN(cond, bar) do { unsigned _sp = 0; while (cond) { __builtin_amdgcn_s_sleep(1); \
    if ((++_sp & 255u) == 0u) { if (xb_ld(&(bar)[XB_TMO])) break; if (_sp > XB_SPIN_CAP) { atomicAdd(&(bar)[XB_TMO], 1u); break; } } } } while (0)

__device__ __forceinline__ int lane_id() { int l; asm volatile("v_mbcnt_lo_u32_b32 %0, -1, 0\n\tv_mbcnt_hi_u32_b32 %0, -1, %0" : "=v"(l)); return l; }
struct XcdBarrier {
    int wave; unsigned* bar; unsigned x;
    volatile LAS unsigned* st;
};

__device__ __forceinline__ XcdBarrier xcd_barrier_post(unsigned* bar, volatile LAS unsigned* st, int wave) {
    XcdBarrier b; b.bar = bar; b.x = xb_xcc_id(); b.st = st; b.wave = wave;
    if (wave == 0 && lane_id() == 0) (void)xb_add(&bar[XB_XCNT(b.x)], 1u);
    return b;
}
__device__ __forceinline__ void xcd_barrier_complete(unsigned* bar, unsigned x, unsigned& nloc, unsigned& nx) {
    const unsigned G = gridDim.x * gridDim.y * gridDim.z;
    unsigned sum, cnt, mine, sp = 0u;
    for (;;) {
        sum = 0u; cnt = 0u;
#pragma nounroll
        for (unsigned j = 0; j < 16; ++j) { const unsigned c = xb_ld(&bar[XB_XCNT(j)]); sum += c; cnt += (c > 0u) ? 1u : 0u; }
        if (sum == G) break;
        __builtin_amdgcn_s_sleep(1);
        if ((++sp & 255u) == 0u) { if (xb_ld(&bar[XB_TMO])) break; if (sp > XB_SPIN_CAP) { atomicAdd(&bar[XB_TMO], 1u); break; } }
    }
    mine = xb_ld(&bar[XB_XCNT(x)]);
    nloc = mine > 0u ? mine : 1u; nx = cnt > 0u ? cnt : 1u;
}

__device__ __forceinline__ void xcd_barrier(const XcdBarrier& b) {
    asm volatile("s_waitcnt vmcnt(0)" ::: "memory");
    __syncthreads();
    if (b.wave == 0 && lane_id() == 0) {
        unsigned* bar = b.bar;
        __builtin_amdgcn_s_waitcnt(0);
        unsigned nloc = b.st[0], nx = b.st[1];
        if (nloc == 0u) { xcd_barrier_complete(bar, b.x, nloc, nx); b.st[0] = nloc; b.st[1] = nx; }
        const unsigned old = xb_add(&bar[XB_XSUB(b.x)], 1u);
        const unsigned gen = old / nloc;
        if (old + 1u == (gen + 1u) * nloc) {
            __builtin_amdgcn_fence(__ATOMIC_RELEASE, "agent");
            asm volatile("s_waitcnt vmcnt(0)" ::: "memory");
            const unsigned og = xb_add(&bar[XB_TOP], 1u);
            const unsigned tg = og / nx;
            if (og + 1u == (tg + 1u) * nx) xb_add(&bar[XB_TOPGEN], 1u);
            else XB_SPIN(xb_ld(&bar[XB_TOPGEN]) == tg, bar);
            __builtin_amdgcn_fence(__ATOMIC_ACQUIRE, "agent");
            xb_add(&bar[XB_XGEN(b.x)], 1u);
            asm volatile("s_waitcnt vmcnt(0)" ::: "memory");
        } else {
            XB_SPIN(xb_ld(&bar[XB_XGEN(b.x)]) == gen, bar);
            __builtin_amdgcn_fence(__ATOMIC_ACQUIRE, "agent");
            asm volatile("s_waitcnt vmcnt(0)" ::: "memory");
        }
    }
    __syncthreads();
}
namespace mix {
typedef short bf16x8 __attribute__((ext_vector_type(8)));
typedef short s16x4 __attribute__((ext_vector_type(4)));
typedef float f32x4 __attribute__((ext_vector_type(4)));
typedef float f32x16 __attribute__((ext_vector_type(16)));
typedef unsigned u32x4 __attribute__((ext_vector_type(4)));
typedef unsigned u32x2 __attribute__((ext_vector_type(2)));
constexpr float LOG2E = 1.4426950408889634f;
__device__ __forceinline__ unsigned cvt2(float lo, float hi) { return pg8::cvt_pk_bf16(lo, hi); }
__device__ __forceinline__ float bflo(unsigned w) { return __uint_as_float(w << 16); }
__device__ __forceinline__ float bfhi(unsigned w) { return __uint_as_float(w & 0xffff0000u); }
__device__ __forceinline__ s16x4 tr16(LAS unsigned char* p) { typedef short v4i16_t __attribute__((ext_vector_type(4))); return __builtin_bit_cast(s16x4, __builtin_amdgcn_ds_read_tr16_b64_v4i16((LAS v4i16_t*)p)); }
__device__ __forceinline__ bf16x8 cat8(s16x4 a, s16x4 b) { return (bf16x8){a[0], a[1], a[2], a[3], b[0], b[1], b[2], b[3]}; }
__device__ __forceinline__ bf16x8 u4_to_b8(u32x4 w) { return __builtin_bit_cast(bf16x8, w); }

constexpr int AT_KROW = 144, AT_KEYS = 320, AT_LDS_K = 0, AT_LDS_V = AT_KEYS * AT_KROW;
__device__ __forceinline__ void attn_item(int item, LAS unsigned char* lds, const bf16* AQ, const bf16* AKV, bf16* ATT, const float* sink, int tid_in) {
    int tid = tid_in; asm volatile("" : "+v"(tid));
    const int lane = tid & 63, wid = __builtin_amdgcn_readfirstlane(tid >> 6), r32 = lane & 31, hi = lane >> 5;
    const int qb = item & 63, kvh = (item >> 6) & 1, b = item >> 7;
    const int q0 = qb * 64;
    const size_t rowbase = (size_t)b * SEQ;
#pragma unroll
    for (int i = 0; i < 5; ++i) { const int id = tid + 512 * i, key = id >> 3, c = id & 7; const int pos = q0 - 128 + key;
        if (pos >= 0 && pos < SEQ) { const bf16* src = AKV + (rowbase + pos) * 256 + kvh * 64 + c * 8;
            const u32x4 kk = *(const u32x4*)src, vv = *(const u32x4*)(src + 128);
            *(LAS u32x4*)(lds + AT_LDS_K + key * AT_KROW + c * 16) = kk;
            *(LAS u32x4*)(lds + AT_LDS_V + key * 128 + (((c >> 2) ^ ((key >> 1) & 1)) << 6) + (c & 3) * 16) = vv; } }
    const int g4 = wid & 3, rh = wid >> 2, hq = kvh * 4 + g4;
    const int qrow0 = q0 + 32 * rh;
    bf16x8 qf[4];
    { const bf16* qp = AQ + (rowbase + qrow0 + r32) * 512 + hq * 64 + hi * 8;
#pragma unroll
      for (int ks = 0; ks < 4; ++ks) qf[ks] = u4_to_b8(*(const u32x4*)(qp + ks * 16)); }
    const float sk = sink[hq] * LOG2E;
    float mrun = sk, lsum = (hi == 0) ? 1.0f : 0.0f;
    f32x16 o0 = {}, o1 = {};
    asm volatile("s_waitcnt vmcnt(0) lgkmcnt(0)" ::: "memory"); __builtin_amdgcn_s_barrier(); asm volatile("" ::: "memory");
#pragma nounroll
    for (int t = 0; t < 9; ++t) {
        const int kpos0 = qrow0 - 128 + 32 * t;
        if (kpos0 < 0 || kpos0 >= SEQ) continue;
        const int kl0 = 32 * rh + 32 * t;
        f32x16 s = {};
        { LAS unsigned char* kp = lds + AT_LDS_K + (kl0 + r32) * AT_KROW + hi * 16;
#pragma unroll
          for (int ks = 0; ks < 4; ++ks) { const bf16x8 kf = *(LAS bf16x8*)(kp + ks * 32); s = __builtin_amdgcn_mfma_f32_32x32x16_bf16(kf, qf[ks], s, 0, 0, 0); } }
        if (t == 0) {
#pragma unroll
            for (int i = 0; i < 16; ++i) { const int c = (i & 3) + 8 * (i >> 2) + 4 * hi; if (c < r32) s[i] = -INFINITY; }
        } else if (t == 8) {
#pragma unroll
            for (int i = 0; i < 16; ++i) { const int c = (i & 3) + 8 * (i >> 2) + 4 * hi; if (c > r32) s[i] = -INFINITY; }
        }
        float tm = s[0];
#pragma unroll
        for (int i = 1; i < 16; ++i) tm = fmaxf(tm, s[i]);
        tm = fmaxf(tm, __shfl_xor(tm, 32));
        if (__any(tm > mrun)) {
            const float mnew = fmaxf(mrun, tm), alpha = __builtin_amdgcn_exp2f(mrun - mnew);
            mrun = mnew; lsum *= alpha;
#pragma unroll
            for (int i = 0; i < 16; ++i) { o0[i] *= alpha; o1[i] *= alpha; }
        }
        float ps = 0.f;
#pragma unroll
        for (int i = 0; i < 16; ++i) { s[i] = __builtin_amdgcn_exp2f(s[i] - mrun); ps += s[i]; }
        lsum += ps;
        bf16x8 pf[2];
#pragma unroll
        for (int ks = 0; ks < 2; ++ks) { u32x4 w; w.x = cvt2(s[8 * ks + 0], s[8 * ks + 1]); w.y = cvt2(s[8 * ks + 2], s[8 * ks + 3]); w.z = cvt2(s[8 * ks + 4], s[8 * ks + 5]); w.w = cvt2(s[8 * ks + 6], s[8 * ks + 7]); pf[ks] = u4_to_b8(w); }
        { const int li = lane & 15, q = li >> 2, p = li & 3, dsel = (lane >> 4) & 1;
#pragma unroll
          for (int ks = 0; ks < 2; ++ks) {
#pragma unroll
            for (int dt = 0; dt < 2; ++dt) {
                const int key_a = kl0 + 16 * ks + 4 * hi + q, key_b = key_a + 8;
                LAS unsigned char* pa = lds + AT_LDS_V + key_a * 128 + ((dt ^ ((key_a >> 1) & 1)) << 6) + dsel * 32 + p * 8;
                LAS unsigned char* pb = lds + AT_LDS_V + key_b * 128 + ((dt ^ ((key_b >> 1) & 1)) << 6) + dsel * 32 + p * 8;
                const bf16x8 vf = cat8(tr16(pa), tr16(pb));
                if (dt == 0) o0 = __builtin_amdgcn_mfma_f32_32x32x16_bf16(vf, pf[ks], o0, 0, 0, 0);
                else         o1 = __builtin_amdgcn_mfma_f32_32x32x16_bf16(vf, pf[ks], o1, 0, 0, 0); } } }
    }
    lsum += __shfl_xor(lsum, 32);
    const float il = 1.0f / lsum;
    bf16* op = ATT + (rowbase + qrow0 + r32) * 512 + hq * 64 + 4 * hi;
#pragma unroll
    for (int gq = 0; gq < 4; ++gq) {
        u32x2 w0, w1; w0.x = cvt2(o0[4 * gq] * il, o0[4 * gq + 1] * il); w0.y = cvt2(o0[4 * gq + 2] * il, o0[4 * gq + 3] * il);
        w1.x = cvt2(o1[4 * gq] * il, o1[4 * gq + 1] * il); w1.y = cvt2(o1[4 * gq + 2] * il, o1[4 * gq + 3] * il);
        *(u32x2*)(op + 8 * gq) = w0; *(u32x2*)(op + 32 + 8 * gq) = w1; }
    asm volatile("s_waitcnt lgkmcnt(0)" ::: "memory"); __builtin_amdgcn_s_barrier(); asm volatile("" ::: "memory");
}

__device__ __forceinline__ void attn_run(int item0, int istep, int nitems, LAS unsigned char* lds, const bf16* AQ, const bf16* AKV, bf16* ATT, const float* sink, int tid_in) {
    int tid = tid_in; asm volatile("" : "+v"(tid));
    const int lane = tid & 63, wid = __builtin_amdgcn_readfirstlane(tid >> 6), r32 = lane & 31, hi = lane >> 5;
    u32x4 pk[5], pv[5];
#define AT_LOADKV(it_) do { const int qb_ = (it_) & 63, kvh_ = ((it_) >> 6) & 1, b_ = (it_) >> 7; \
        _Pragma("unroll") for (int i = 0; i < 5; ++i) { const int id = tid + 512 * i, key = id >> 3, c = id & 7; const int pos = qb_ * 64 - 128 + key; \
            if (pos >= 0 && pos < SEQ) { const bf16* src = AKV + ((size_t)b_ * SEQ + pos) * 256 + kvh_ * 64 + c * 8; pk[i] = *(const u32x4*)src; pv[i] = *(const u32x4*)(src + 128); } } } while (0)
    if (item0 < nitems) AT_LOADKV(item0);
#pragma nounroll
    for (int item = item0; item < nitems; item += istep) {
    const int qb = item & 63, kvh = (item >> 6) & 1, b = item >> 7;
    const int q0 = qb * 64;
    const size_t rowbase = (size_t)b * SEQ;
#pragma unroll
    for (int i = 0; i < 5; ++i) { const int id = tid + 512 * i, key = id >> 3, c = id & 7; const int pos = q0 - 128 + key;
        if (pos >= 0 && pos < SEQ) {
            *(LAS u32x4*)(lds + AT_LDS_K + key * AT_KROW + c * 16) = pk[i];
            *(LAS u32x4*)(lds + AT_LDS_V + key * 128 + (((c >> 2) ^ ((key >> 1) & 1)) << 6) + (c & 3) * 16) = pv[i]; } }
    const int g4 = wid & 3, rh = wid >> 2, hq = kvh * 4 + g4;
    const int qrow0 = q0 + 32 * rh;
    bf16x8 qf[4];
    { const bf16* qp = AQ + (rowbase + qrow0 + r32) * 512 + hq * 64 + hi * 8;
#pragma unroll
      for (int ks = 0; ks < 4; ++ks) qf[ks] = u4_to_b8(*(const u32x4*)(qp + ks * 16)); }
    if (item + istep < nitems) AT_LOADKV(item + istep);
    const float sk = sink[hq] * LOG2E;
    float mrun = sk, lsum = (hi == 0) ? 1.0f : 0.0f;
    f32x16 o0 = {}, o1 = {};
    asm volatile("s_waitcnt lgkmcnt(0)" ::: "memory"); __builtin_amdgcn_s_barrier(); asm volatile("" ::: "memory");
#pragma nounroll
    for (int t = 0; t < 9; ++t) {
        const int kpos0 = qrow0 - 128 + 32 * t;
        if (kpos0 < 0 || kpos0 >= SEQ) continue;
        const int kl0 = 32 * rh + 32 * t;
        f32x16 s = {};
        { LAS unsigned char* kp = lds + AT_LDS_K + (kl0 + r32) * AT_KROW + hi * 16;
#pragma unroll
          for (int ks = 0; ks < 4; ++ks) { const bf16x8 kf = *(LAS bf16x8*)(kp + ks * 32); s = __builtin_amdgcn_mfma_f32_32x32x16_bf16(kf, qf[ks], s, 0, 0, 0); } }
        if (t == 0) {
#pragma unroll
            for (int i = 0; i < 16; ++i) { const int c = (i & 3) + 8 * (i >> 2) + 4 * hi; if (c < r32) s[i] = -INFINITY; }
        } else if (t == 8) {
#pragma unroll
            for (int i = 0; i < 16; ++i) { const int c = (i & 3) + 8 * (i >> 2) + 4 * hi; if (c > r32) s[i] = -INFINITY; }
        }
        float tm = s[0];
#pragma unroll
        for (int i = 1; i < 16; ++i) tm = fmaxf(tm, s[i]);
        tm = fmaxf(tm, __shfl_xor(tm, 32));
        if (__any(tm > mrun)) {
            const float mnew = fmaxf(mrun, tm), alpha = __builtin_amdgcn_exp2f(mrun - mnew);
            mrun = mnew; lsum *= alpha;
#pragma unroll
            for (int i = 0; i < 16; ++i) { o0[i] *= alpha; o1[i] *= alpha; }
        }
        float ps = 0.f;
#pragma unroll
        for (int i = 0; i < 16; ++i) { s[i] = __builtin_amdgcn_exp2f(s[i] - mrun); ps += s[i]; }
        lsum += ps;
        bf16x8 pf[2];
#pragma unroll
        for (int ks = 0; ks < 2; ++ks) { u32x4 w; w.x = cvt2(s[8 * ks + 0], s[8 * ks + 1]); w.y = cvt2(s[8 * ks + 2], s[8 * ks + 3]); w.z = cvt2(s[8 * ks + 4], s[8 * ks + 5]); w.w = cvt2(s[8 * ks + 6], s[8 * ks + 7]); pf[ks] = u4_to_b8(w); }
        { const int li = lane & 15, q = li >> 2, p = li & 3, dsel = (lane >> 4) & 1;
#pragma unroll
          for (int ks = 0; ks < 2; ++ks) {
#pragma unroll
            for (int dt = 0; dt < 2; ++dt) {
                const int key_a = kl0 + 16 * ks + 4 * hi + q, key_b = key_a + 8;
                LAS unsigned char* pa = lds + AT_LDS_V + key_a * 128 + ((dt ^ ((key_a >> 1) & 1)) << 6) + dsel * 32 + p * 8;
                LAS unsigned char* pb = lds + AT_LDS_V + key_b * 128 + ((dt ^ ((key_b >> 1) & 1)) << 6) + dsel * 32 + p * 8;
                const bf16x8 vf = cat8(tr16(pa), tr16(pb));
                if (dt == 0) o0 = __builtin_amdgcn_mfma_f32_32x32x16_bf16(vf, pf[ks], o0, 0, 0, 0);
                else         o1 = __builtin_amdgcn_mfma_f32_32x32x16_bf16(vf, pf[ks], o1, 0, 0, 0); } } }
    }
    lsum += __shfl_xor(lsum, 32);
    const float il = 1.0f / lsum;
    bf16* op = ATT + (rowbase + qrow0 + r32) * 512 + hq * 64 + 8 * hi;
#pragma unroll
    for (int gp = 0; gp < 2; ++gp) {
#pragma unroll
        for (int hf = 0; hf < 2; ++hf) {
            unsigned ax, ay, bx_, by_;
            if (hf == 0) { ax = cvt2(o0[8 * gp] * il, o0[8 * gp + 1] * il); ay = cvt2(o0[8 * gp + 2] * il, o0[8 * gp + 3] * il); bx_ = cvt2(o0[8 * gp + 4] * il, o0[8 * gp + 5] * il); by_ = cvt2(o0[8 * gp + 6] * il, o0[8 * gp + 7] * il); }
            else         { ax = cvt2(o1[8 * gp] * il, o1[8 * gp + 1] * il); ay = cvt2(o1[8 * gp + 2] * il, o1[8 * gp + 3] * il); bx_ = cvt2(o1[8 * gp + 4] * il, o1[8 * gp + 5] * il); by_ = cvt2(o1[8 * gp + 6] * il, o1[8 * gp + 7] * il); }
            { auto r = __builtin_amdgcn_permlane32_swap(ax, bx_, false, false); ax = r[0]; bx_ = r[1]; }
            { auto r = __builtin_amdgcn_permlane32_swap(ay, by_, false, false); ay = r[0]; by_ = r[1]; }
            u32x4 w; w.x = ax; w.y = ay; w.z = bx_; w.w = by_;
            *(u32x4*)(op + 32 * hf + 16 * gp) = w; } }
    asm volatile("s_waitcnt lgkmcnt(0)" ::: "memory"); __builtin_amdgcn_s_barrier(); asm volatile("" ::: "memory");
    }
#undef AT_LOADKV
}

constexpr int ML_BUF = 49152, ML_Q = 0, ML_K = 16384, ML_V = 32768, ML_SC = 98304, ML_ARR = 106496, ML_ARRP = 2560;
constexpr int MA_A = 0, MA_M = 256, MA_WI = 512, MA_EN = 768, MA_WK = 1024, MA_SCAL = 1280;
constexpr int MB_DEN = 2 * ML_ARRP, MB_QN = MB_DEN + 512, MB_NV = MB_QN + 256;
__device__ __forceinline__ int swc(int row) { return (row & 3) | (((row >> 3) & 1) << 2); }
__device__ __forceinline__ int ml_off(int row, int dim) { return row * 256 + (((dim >> 4) ^ swc(row)) << 5) + (dim & 15) * 2; }
__device__ __forceinline__ int sc_off(int j, int t) { return j * 128 + ((((t >> 3)) ^ ((j >> 1) & 7)) << 4) + (t & 7) * 2; }
__device__ __forceinline__ float dppf(float old, float src, const int ctrl_sel) {
    const int o = __float_as_int(old), v = __float_as_int(src); int r;
    switch (ctrl_sel) {
        case 1: r = __builtin_amdgcn_update_dpp(o, v, 0x111, 0xf, 0xf, false); break;
        case 2: r = __builtin_amdgcn_update_dpp(o, v, 0x112, 0xf, 0xf, false); break;
        case 4: r = __builtin_amdgcn_update_dpp(o, v, 0x114, 0xf, 0xf, false); break;
        case 8: r = __builtin_amdgcn_update_dpp(o, v, 0x118, 0xf, 0xf, false); break;
        case 15: r = __builtin_amdgcn_update_dpp(o, v, 0x142, 0xa, 0xf, false); break;
        default: r = __builtin_amdgcn_update_dpp(o, v, 0x143, 0xc, 0xf, false); break;
    }
    return __int_as_float(r);
}
__device__ __forceinline__ float wave_scan_add(float x) { x += dppf(0.f, x, 1); x += dppf(0.f, x, 2); x += dppf(0.f, x, 4); x += dppf(0.f, x, 8); x += dppf(0.f, x, 15); x += dppf(0.f, x, 31); return x; }
__device__ __forceinline__ float wave_scan_max(float x) { const float ni = -INFINITY; x = fmaxf(x, dppf(ni, x, 1)); x = fmaxf(x, dppf(ni, x, 2)); x = fmaxf(x, dppf(ni, x, 4)); x = fmaxf(x, dppf(ni, x, 8)); x = fmaxf(x, dppf(ni, x, 15)); x = fmaxf(x, dppf(ni, x, 31)); return x; }
constexpr int M3_Q = 0, M3_K = 49152, M3_V = 98304, M3_SC = 131072, M3_ARR = 147456, M3_ARRS = 1536, M3_DEN = 152064, M3_QN = 152576, M3_NV = 152832, M3_FLAG = 153344, M3_END = 153600;
template <int MODE = 0>
__device__ __forceinline__ void mlstm_item3(int item, LAS unsigned char* lds, const bf16* CQK, const bf16* MV, const float* GATES, bf16* HSF, bf16* HSB, int tid_in) {
    int tid = tid_in; asm volatile("" : "+v"(tid));
    const int lane = tid & 63, wid = __builtin_amdgcn_readfirstlane(tid >> 6), l15 = lane & 15, g = lane >> 4;
    const int dvh = item & 1, dir = (item >> 1) & 1, h = (item >> 2) & 3, b = item >> 4;
    bf16* HS = dir ? HSB : HSF;
    const size_t rowbase = (size_t)b * SEQ;
    LAS float* aDEN = (LAS float*)(lds + M3_DEN); LAS float* aQN = (LAS float*)(lds + M3_QN); LAS float* aNV = (LAS float*)(lds + M3_NV); LAS unsigned* aFLAG = (LAS unsigned*)(lds + M3_FLAG);
#define M3_GROW(c, row) (rowbase + (size_t)(dir ? (SEQ - 1 - (64 * (c) + (row))) : (64 * (c) + (row))))
#define M3_BAR() do { asm volatile("s_waitcnt lgkmcnt(0)" ::: "memory"); __builtin_amdgcn_s_barrier(); asm volatile("" ::: "memory"); } while (0)
    if (tid < 128) aNV[tid] = 0.f;
    __builtin_amdgcn_s_waitcnt(0);
    if (tid < 4) aFLAG[tid] = 0u;
    if (wid >= 4) {
        const int tt_ = tid - 256;
        u32x4 pqA[4], pkA[4], pvA[4], pqB[4], pkB[4], pvB[4]; float gliA = 0.f, glfA = 0.f, gliB = 0.f, glfB = 0.f, m_prev = 0.f;
        int wo_, tq_[4], tw_[4];
        unsigned lo_ = (unsigned)(((dir ? 63 - (tt_ >> 4) : (tt_ >> 4)) * 1024 + (tt_ & 15) * 8) * 2), go_ = (unsigned)((dir ? 63 - lane : lane) * 64);
        asm volatile("" : "+v"(lo_), "+v"(go_));
        { const int swl = swc(l15), s2 = (l15 >> 1) & 7;
          wo_ = ml_off(tt_ >> 4, (tt_ & 15) * 8);
#pragma unroll
          for (int ks = 0; ks < 4; ++ks) tq_[ks] = l15 * 256 + (((2 * ks + (g >> 1)) ^ swl) << 5) + (g & 1) * 16;
#pragma unroll
          for (int tt = 0; tt < 4; ++tt) tw_[tt] = l15 * 128 + (((2 * tt + (g >> 1)) ^ s2) << 4) + (g & 1) * 8;
          asm volatile("" : "+v"(wo_));
#pragma unroll
          for (int k = 0; k < 4; ++k) asm volatile("" : "+v"(tq_[k]), "+v"(tw_[k])); }
#define M3_CBASE(c) ((size_t)(rowbase + (size_t)(dir ? SEQ - 64 * ((c) + 1) : 64 * (c))))
#define M3_LOAD_QK(c, S) do { const char* qb_ = (const char*)(CQK + M3_CBASE(c) * 1024 + h * 128); _Pragma("unroll") for (int i = 0; i < 4; ++i) { const char* p_ = qb_ + (dir ? -32768 * i : 32768 * i); \
            pq##S[i] = *(const u32x4*)(p_ + lo_); pk##S[i] = *(const u32x4*)(p_ + 1024 + lo_); } } while (0)
#define M3_LOAD_V(c, S) do { const char* vb_ = (const char*)(MV + M3_CBASE(c) * 1024 + h * 256 + dvh * 128); _Pragma("unroll") for (int i = 0; i < 4; ++i) { \
            pv##S[i] = *(const u32x4*)(vb_ + (dir ? -32768 * i : 32768 * i) + lo_); } } while (0)
#define M3_LOAD_G(c, S) do { const char* gb_ = (const char*)(GATES + M3_CBASE(c) * 16 + dir * 8 + h); gli##S = *(const float*)(gb_ + go_); glf##S = *(const float*)(gb_ + 16 + go_); } while (0)
#define M3_WRITE_QK(c, S) do { const int qo_ = ((c) % 3) * 16384; _Pragma("unroll") for (int i = 0; i < 4; ++i) { const int off = qo_ + wo_ + 4096 * i; \
            *(LAS u32x4*)(lds + M3_Q + off) = pq##S[i]; *(LAS u32x4*)(lds + M3_K + off) = pk##S[i]; } } while (0)
#define M3_WRITE_V(c, S) do { const int vo_ = ((c) & 1) * 16384; _Pragma("unroll") for (int i = 0; i < 4; ++i) { \
            *(LAS u32x4*)(lds + M3_V + vo_ + wo_ + 4096 * i) = pv##S[i]; } } while (0)
#define M3_GATES(c, S) do { if (wid == 7) { LAS float* A_ = (LAS float*)(lds + M3_ARR + ((c) % 3) * M3_ARRS); \
            const float bsum = wave_scan_add(glf##S); const float a = gli##S - bsum; const float pm = wave_scan_max(a); const float Mj = fmaxf(m_prev, pm); \
            const float M63 = __shfl(Mj, 63), b63 = __shfl(bsum, 63); \
            A_[MA_A / 4 + lane] = a * LOG2E; A_[MA_M / 4 + lane] = Mj * LOG2E; A_[MA_WI / 4 + lane] = __builtin_amdgcn_exp2f((m_prev - Mj) * LOG2E); A_[MA_EN / 4 + lane] = __builtin_amdgcn_exp2f(-(bsum + Mj) * LOG2E); \
            A_[MA_WK / 4 + lane] = __builtin_amdgcn_exp2f((a - M63) * LOG2E); if (lane == 0) A_[MA_SCAL / 4] = __builtin_amdgcn_exp2f((m_prev - M63) * LOG2E); \
            m_prev = b63 + M63; } } while (0)
#define M3_SCORE_ROWS(c, jt) do { const int qo_ = ((c) % 3) * 16384; LAS float* A_ = (LAS float*)(lds + M3_ARR + ((c) % 3) * M3_ARRS); const int j = 16 * (jt) + l15; \
            bf16x8 qb_[4]; _Pragma("unroll") for (int ks = 0; ks < 4; ++ks) qb_[ks] = *(LAS bf16x8*)(lds + M3_Q + qo_ + tq_[ks] + 4096 * (jt)); \
            const float Mj = A_[MA_M / 4 + j]; float rs = 0.f; \
            _Pragma("unroll") for (int tt = 0; tt < 4; ++tt) { f32x4 sc = {0.f, 0.f, 0.f, 0.f}; \
                if (tt <= (jt)) { f32x4 d = {0.f, 0.f, 0.f, 0.f}; const int trow = 16 * tt + l15; \
                    _Pragma("unroll") for (int ks = 0; ks < 4; ++ks) { const bf16x8 kf = *(LAS bf16x8*)(lds + M3_K + qo_ + tq_[ks] + 4096 * tt); d = __builtin_amdgcn_mfma_f32_16x16x32_bf16(kf, qb_[ks], d, 0, 0, 0); } \
                    const f32x4 a4 = *(LAS f32x4*)(A_ + MA_A / 4 + 16 * tt + 4 * g); \
                    _Pragma("unroll") for (int r = 0; r < 4; ++r) { const int t = 16 * tt + 4 * g + r; const float w = (t <= j) ? __builtin_amdgcn_exp2f(a4[r] - Mj) : 0.f; sc[r] = d[r] * w; rs += sc[r]; } } \
                u32x2 pk_; pk_.x = cvt2(sc[0], sc[1]); pk_.y = cvt2(sc[2], sc[3]); \
                *(LAS u32x2*)(lds + M3_SC + ((c) & 1) * 8192 + tw_[tt] + 2048 * (jt)) = pk_; } \
            rs += __shfl_xor(rs, 16); rs += __shfl_xor(rs, 32); \
            if (g == 0) aDEN[64 * ((c) & 1) + j] = rs; } while (0)
#define M3_SCORES(c) do { if (wid == 4) M3_SCORE_ROWS(c, 3); else if (wid == 5) M3_SCORE_ROWS(c, 2); else if (wid == 6) { M3_SCORE_ROWS(c, 1); M3_SCORE_ROWS(c, 0); } } while (0)
        if (MODE != 2) { M3_LOAD_QK(0, A); M3_LOAD_V(0, A); M3_LOAD_G(0, A); M3_WRITE_QK(0, A); M3_WRITE_V(0, A); M3_GATES(0, A);
        M3_LOAD_QK(1, A); M3_LOAD_G(1, A); M3_WRITE_QK(1, A); M3_GATES(1, A);
        M3_LOAD_QK(2, A); M3_LOAD_G(2, A); M3_LOAD_V(1, A); M3_LOAD_QK(3, B); M3_LOAD_G(3, B); M3_LOAD_V(2, B); }
        M3_BAR();
        if (MODE != 2) M3_SCORES(0);
        M3_BAR();
#define M3_TSTEP(c, S) do { \
            if ((c) + 2 < 64) M3_WRITE_QK((c) + 2, S); \
            if ((c) + 1 < 64) M3_WRITE_V((c) + 1, S); \
            if ((c) + 2 < 64) M3_GATES((c) + 2, S); \
            if ((c) + 4 < 64) { M3_LOAD_QK((c) + 4, S); M3_LOAD_G((c) + 4, S); } \
            if ((c) + 3 < 64) M3_LOAD_V((c) + 3, S); \
            if ((c) + 1 < 64) M3_SCORES((c) + 1); \
            M3_BAR(); } while (0)
#pragma nounroll
        for (int c = 0; c < 64; c += 2) {
            if (MODE == 2) { M3_BAR(); M3_BAR(); continue; }
            M3_TSTEP(c, A);
            M3_TSTEP(c + 1, B);
        }
#undef M3_TSTEP
    } else {
        const int s_ = wid;
        f32x4 C[8][2]; f32x4 nst[2] = {{0.f, 0.f, 0.f, 0.f}, {0.f, 0.f, 0.f, 0.f}};
#pragma unroll
        for (int T = 0; T < 8; ++T) { C[T][0] = (f32x4){0.f, 0.f, 0.f, 0.f}; C[T][1] = (f32x4){0.f, 0.f, 0.f, 0.f}; }
        M3_BAR();
        M3_BAR();
        const int q4 = l15 >> 2, p4 = l15 & 3;
        int qA[4], qB[4], kT[8], kN[2], sK[2], hoff;
        { const int swl = swc(l15), swt = q4 | ((g & 1) << 2), s2 = (l15 >> 1) & 7;
#pragma unroll
          for (int ks = 0; ks < 4; ++ks) { qA[ks] = l15 * 256 + (((2 * ks) ^ swl) << 5) + 8 * g; qB[ks] = l15 * 256 + (((2 * ks + 1) ^ swl) << 5) + 8 * g; }
#pragma unroll
          for (int T = 0; T < 8; ++T) kT[T] = (8 * g + q4) * 256 + ((T ^ swt) << 5) + 8 * p4;
#pragma unroll
          for (int tn = 0; tn < 2; ++tn) kN[tn] = (8 * g + q4) * 256 + (((2 * s_ + tn) ^ swt) << 5) + 8 * p4;
#pragma unroll
          for (int ks = 0; ks < 2; ++ks) sK[ks] = l15 * 128 + (((4 * ks + g) ^ s2) << 4);
          hoff = (dir ? 15 - l15 : l15) * 2048 + 8 * g;
#pragma unroll
          for (int ks = 0; ks < 4; ++ks) asm volatile("" : "+v"(qA[ks]), "+v"(qB[ks]));
#pragma unroll
          for (int T = 0; T < 8; ++T) asm volatile("" : "+v"(kT[T]));
          asm volatile("" : "+v"(kN[0]), "+v"(kN[1]), "+v"(sK[0]), "+v"(sK[1]), "+v"(hoff)); }
#pragma nounroll
        for (int c = 0; c < 64; ++c) {
            if (MODE == 1) { M3_BAR(); continue; }
            const int qo = (c % 3) * 16384, vo = (c & 1) * 16384, par = c & 1;
            LAS float* A_ = (LAS float*)(lds + M3_ARR + (c % 3) * M3_ARRS);
            LAS unsigned char* const Qb = lds + M3_Q + qo; LAS unsigned char* const Kb = lds + M3_K + qo; LAS unsigned char* const Vb = lds + M3_V + vo; LAS unsigned char* const Sb = lds + M3_SC + par * 8192;
            { f32x4 qn = {0.f, 0.f, 0.f, 0.f};
#pragma unroll
              for (int ks = 0; ks < 4; ++ks) {
                  const u32x2 a0 = *(LAS u32x2*)(Qb + s_ * 4096 + qA[ks]), a1 = *(LAS u32x2*)(Qb + s_ * 4096 + qB[ks]);
                  const f32x4 n0 = *(LAS f32x4*)(aNV + 32 * ks + 4 * g), n1 = *(LAS f32x4*)(aNV + 32 * ks + 16 + 4 * g);
                  u32x4 aw; aw.x = a0.x; aw.y = a0.y; aw.z = a1.x; aw.w = a1.y;
                  u32x4 bw; bw.x = cvt2(n0[0], n0[1]); bw.y = cvt2(n0[2], n0[3]); bw.z = cvt2(n1[0], n1[1]); bw.w = cvt2(n1[2], n1[3]);
                  qn = __builtin_amdgcn_mfma_f32_16x16x32_bf16(u4_to_b8(aw), u4_to_b8(bw), qn, 0, 0, 0); }
              if (l15 == 0) *(LAS f32x4*)(aQN + 16 * s_ + 4 * g) = qn;
              asm volatile("s_waitcnt lgkmcnt(0)" ::: "memory");
              if (lane == 0) aFLAG[s_] = (unsigned)(c + 1);
              asm volatile("" ::: "memory"); }
            bf16x8 vb[2][2], Cb[4][2];
#pragma unroll
            for (int nt = 0; nt < 2; ++nt) {
#pragma unroll
                for (int ks = 0; ks < 2; ++ks) vb[ks][nt] = cat8(tr16(Vb + kN[nt] + ks * 8192), tr16(Vb + kN[nt] + ks * 8192 + 1024));
#pragma unroll
                for (int ks = 0; ks < 4; ++ks) { u32x4 w; w.x = cvt2(C[2 * ks][nt][0], C[2 * ks][nt][1]); w.y = cvt2(C[2 * ks][nt][2], C[2 * ks][nt][3]); w.z = cvt2(C[2 * ks + 1][nt][0], C[2 * ks + 1][nt][1]); w.w = cvt2(C[2 * ks + 1][nt][2], C[2 * ks + 1][nt][3]); Cb[ks][nt] = u4_to_b8(w); } }
#pragma unroll
            for (int mt = 0; mt < 4; ++mt) { const int j = 16 * mt + l15;
                f32x4 sv[2] = {{0.f, 0.f, 0.f, 0.f}, {0.f, 0.f, 0.f, 0.f}}, in[2] = {{0.f, 0.f, 0.f, 0.f}, {0.f, 0.f, 0.f, 0.f}};
#pragma unroll
                for (int ks = 0; ks < 2; ++ks) if (ks == 0 || mt >= 2) { const bf16x8 af = *(LAS bf16x8*)(Sb + sK[ks] + mt * 2048);
                    sv[0] = __builtin_amdgcn_mfma_f32_16x16x32_bf16(vb[ks][0], af, sv[0], 0, 0, 0); sv[1] = __builtin_amdgcn_mfma_f32_16x16x32_bf16(vb[ks][1], af, sv[1], 0, 0, 0); }
#pragma unroll
                for (int ks = 0; ks < 4; ++ks) {
                    const u32x2 a0 = *(LAS u32x2*)(Qb + qA[ks] + mt * 4096), a1 = *(LAS u32x2*)(Qb + qB[ks] + mt * 4096);
                    u32x4 aw; aw.x = a0.x; aw.y = a0.y; aw.z = a1.x; aw.w = a1.y;
                    in[0] = __builtin_amdgcn_mfma_f32_16x16x32_bf16(Cb[ks][0], u4_to_b8(aw), in[0], 0, 0, 0); in[1] = __builtin_amdgcn_mfma_f32_16x16x32_bf16(Cb[ks][1], u4_to_b8(aw), in[1], 0, 0, 0); }
                if (mt == 0) {
                    for (;;) { asm volatile("" ::: "memory"); const u32x4 f = *(LAS u32x4*)aFLAG; const unsigned mn = min(min(f.x, f.y), min(f.z, f.w));
                        if (__builtin_amdgcn_readfirstlane((int)mn) >= c + 1) break; __builtin_amdgcn_s_sleep(1); } }
                const float wi = A_[MA_WI / 4 + j], den = aDEN[64 * par + j] + wi * aQN[j];
                const float inv = __builtin_amdgcn_rcpf(fmaxf(fabsf(den), A_[MA_EN / 4 + j]));
                char* const ub = (char*)(HS + (rowbase + (size_t)(dir ? SEQ - 16 - (64 * c + 16 * mt) : 64 * c + 16 * mt)) * 1024 + h * 256 + dvh * 128 + 32 * s_);
#pragma unroll
                for (int nt = 0; nt < 2; ++nt) { u32x2 o; o.x = cvt2((sv[nt][0] + wi * in[nt][0]) * inv, (sv[nt][1] + wi * in[nt][1]) * inv); o.y = cvt2((sv[nt][2] + wi * in[nt][2]) * inv, (sv[nt][3] + wi * in[nt][3]) * inv);
                    *(u32x2*)(ub + (unsigned)hoff + 32 * nt) = o; } }
            { const float decay = A_[MA_SCAL / 4];
              bf16x8 vw[2][2]; bf16x8 wkb[2];
#pragma unroll
              for (int ks = 0; ks < 2; ++ks) { const f32x4 w0 = *(LAS f32x4*)(A_ + MA_WK / 4 + 32 * ks + 8 * g), w1 = *(LAS f32x4*)(A_ + MA_WK / 4 + 32 * ks + 8 * g + 4);
#pragma unroll
                  for (int nt = 0; nt < 2; ++nt) { const u32x4 v = __builtin_bit_cast(u32x4, vb[ks][nt]); u32x4 o;
                      o.x = cvt2(bflo(v.x) * w0[0], bfhi(v.x) * w0[1]); o.y = cvt2(bflo(v.y) * w0[2], bfhi(v.y) * w0[3]); o.z = cvt2(bflo(v.z) * w1[0], bfhi(v.z) * w1[1]); o.w = cvt2(bflo(v.w) * w1[2], bfhi(v.w) * w1[3]);
                      vw[ks][nt] = u4_to_b8(o); }
                  u32x4 wk; wk.x = cvt2(w0[0], w0[1]); wk.y = cvt2(w0[2], w0[3]); wk.z = cvt2(w1[0], w1[1]); wk.w = cvt2(w1[2], w1[3]); wkb[ks] = u4_to_b8(wk); }
              f32x4 nacc[2] = {{0.f, 0.f, 0.f, 0.f}, {0.f, 0.f, 0.f, 0.f}};
#pragma unroll
              for (int tn = 0; tn < 2; ++tn)
#pragma unroll
                  for (int ks = 0; ks < 2; ++ks) { const bf16x8 kf = cat8(tr16(Kb + kN[tn] + ks * 8192), tr16(Kb + kN[tn] + ks * 8192 + 1024));
                      nacc[tn] = __builtin_amdgcn_mfma_f32_16x16x32_bf16(kf, wkb[ks], nacc[tn], 0, 0, 0); }
#pragma unroll
              for (int T = 0; T < 8; ++T) { C[T][0] = C[T][0] * decay; C[T][1] = C[T][1] * decay;
#pragma unroll
                  for (int ks = 0; ks < 2; ++ks) { const bf16x8 kf = cat8(tr16(Kb + kT[T] + ks * 8192), tr16(Kb + kT[T] + ks * 8192 + 1024));
                      C[T][0] = __builtin_amdgcn_mfma_f32_16x16x32_bf16(kf, vw[ks][0], C[T][0], 0, 0, 0); C[T][1] = __builtin_amdgcn_mfma_f32_16x16x32_bf16(kf, vw[ks][1], C[T][1], 0, 0, 0); } }
#pragma unroll
              for (int tn = 0; tn < 2; ++tn) { nst[tn] = nst[tn] * decay + nacc[tn]; if (l15 == 0) *(LAS f32x4*)(aNV + 16 * (2 * s_ + tn) + 4 * g) = nst[tn]; } }
            M3_BAR();
        }
    }
#undef M3_GROW
#undef M3_BAR
#undef M3_LOAD_QK
#undef M3_CBASE
#undef M3_LOAD_V
#undef M3_LOAD_G
#undef M3_WRITE_QK
#undef M3_WRITE_V
#undef M3_GATES
#undef M3_SCORE_ROWS
#undef M3_SCORES
}
}
struct Args { const float* in[25]; float* out; unsigned char* ws; int ph_lo, ph_hi, li, pad; };
__device__ __forceinline__ float wave_sum(float v) {
#pragma unroll
    for (int o = 1; o < 64; o <<= 1) v += __shfl_xor(v, o);
    return v;
}
__device__ __forceinline__ int colmap(int map, int n) {
    if (map == 1) { const int pn = n >> 8, r = n & 255; return (r >> 7) * FFN + 128 * pn + (r & 127); }
    if (map == 2) { if (n >= 3840) return (n < 3856) ? n : -1;
                    if (n < 640 && (n & 63) < 16) { const int p = n & 15; return (n - p) + 4 * (p >> 3) + 8 * ((p >> 2) & 1) + (p & 3); } return n; }
    if (map == 3) return 3856 + n;
    return n;
}
__device__ __forceinline__ float colscale(int map, int n) {
    if (map == 1) return ((n & 255) < 128) ? -1.4426950408889634f : -0.6931471805599453f;
    if (map == 2) return (n >= 2816 && n < 3840) ? -1.4426950408889634f : 1.0f;
    if (map == 3 || map == 4) return -1.4426950408889634f;
    return 1.0f;
}
__device__ __forceinline__ void p0_item3(const float* __restrict__ W, int K, int Nsrc, int Ndst, bf16* __restrict__ WT, const float* __restrict__ gain, int map, int item, int lane_, LAS float* T) {
    const int nblk = Ndst / 64, kb = item / nblk, nb = item % nblk, k0 = 64 * kb, n0 = 64 * nb;
    const int c4 = lane_ & 15, kr = lane_ >> 4;
    const int sc = colmap(map, n0 + 4 * c4); const float cs = colscale(map, n0 + 4 * c4);
    f32x4 v[16];
#pragma unroll
    for (int i = 0; i < 16; ++i) { v[i] = (f32x4){0.f, 0.f, 0.f, 0.f}; if (sc >= 0) v[i] = __builtin_nontemporal_load((const GAS f32x4*)(W + (size_t)(k0 + 4 * i + kr) * Nsrc + sc)); }
#pragma unroll
    for (int i = 0; i < 16; ++i) { const int k = 4 * i + kr; float g = cs; if (gain) g = gain[k0 + k] * cs;
        *(LAS f32x4*)(T + k * 64 + ((c4 ^ ((k >> 3) & 7)) << 2)) = v[i] * g; }
    LDS_WAIT(); asm volatile("" ::: "memory");
    const int oct = lane_ & 7;
#pragma unroll
    for (int j = 0; j < 8; ++j) { const int n = (lane_ >> 3) + 8 * j; const int col = (((n >> 2) ^ oct) << 2) | (n & 3);
        const LAS float* t = T + (8 * oct) * 64 + col;
        v4u o; o.x = pk2(t[0], t[64]); o.y = pk2(t[128], t[192]); o.z = pk2(t[256], t[320]); o.w = pk2(t[384], t[448]);
        *(GAS v4u*)(WT + (size_t)(n0 + n) * K + k0 + 8 * oct) = o; }
    LDS_WAIT(); asm volatile("" ::: "memory");
}
__global__ void __launch_bounds__(NWAVES * 64, 2) mk_fwd(Args args) {
    extern __shared__ __attribute__((aligned(16))) unsigned char lds[];
    LAS unsigned char* const L = (LAS unsigned char*)lds;
    volatile LAS unsigned* const MISC = (volatile LAS unsigned*)(L + MISC_OFF);
    const int wave = __builtin_amdgcn_readfirstlane((int)threadIdx.x >> 6);
#define tid (wave * 64 + lane_id())
#define lane (lane_id())
    const int G = gridDim.x; const int bx = blockIdx.x; const int vcu = (G % 8 == 0) ? (bx % 8) * (G / 8) + bx / 8 : bx;
    unsigned char* const ws = args.ws;
    gu32* const ctl = (gu32*)(ws + WS_CTL);
    for (int u = tid; u < (LDS_BYTES - LDSCTL_OFF) / 4; u += NWAVES * 64) ((LAS unsigned*)(L + LDSCTL_OFF))[u] = 0u;
    __syncthreads();
    XcdBarrier bar = xcd_barrier_post((unsigned*)(ctl + CW_BAR) + args.li * XCD_BAR_WORDS, MISC + 8, wave);
    const int lo = args.ph_lo, hi = args.ph_hi;
    bf16* const XN = (bf16*)(ws + WS_XN);
    float* const INV = (float*)(ws + WS_SSQ);
    float* const ROPE_C = (float*)(ws + WS_ROPE); float* const ROPE_S = ROPE_C + SEQ * 8;
    const int gw = vcu * NWAVES + wave, NGW = G * NWAVES;

#define IN(k) (lo <= (k) && (k) < hi)
#define SEAM(k) do { if (lo <= (k) && (k) + 1 < hi) xcd_barrier(bar); } while (0)
    if (IN(0)) {
        {
        {
            struct WD { int src; int K, Nsrc, Ndst; size_t dst; int gain; int map; };
            const WD wd[11] = { {3, 1024, 5632, 5632, WS_W1A, 2, 1}, {4, 2816, 1024, 1024, WS_W2A, -1, 0}, {7, 1024, INW, 4096, WS_WINA, 6, 2}, {7, 1024, INW, 2048, WS_WINB, 6, 3},
                                {13, 512, 1024, 1024, WS_WBA, -1, 0}, {14, 1024, 1024, 1024, WS_WBM, -1, 0}, {15, 1024, 1024, 1024, WS_WOUT, -1, 0},
                                {18, 1024, 5632, 5632, WS_W1B, 17, 1}, {19, 2816, 1024, 1024, WS_W2B, -1, 0}, {22, 1024, 1024, 1024, WS_WPG, 21, 4}, {23, 256, 1024, 1024, WS_WPP, -1, 0} };
            int base_it = 0;
            LAS float* Tw = (LAS float*)(L + RING_OFF + wave * 16384);
#pragma unroll
            for (int w = 0; w < 11; ++w) { const int ni = (wd[w].K / 64) * (wd[w].Ndst / 64);
                int first = gw - (base_it % NGW); if (first < 0) first += NGW;
                for (int r = first; r < ni; r += NGW)
                    p0_item3(args.in[wd[w].src], wd[w].K, wd[w].Nsrc, wd[w].Ndst, (bf16*)(ws + wd[w].dst), wd[w].gain >= 0 ? args.in[wd[w].gain] : nullptr, wd[w].map, r, lane, Tw);
                base_it += ni; }
        }
        {
            {
                const float* x = args.in[0];
                for (int m0 = gw * 4; m0 < M; m0 += NGW * 4) {
                    f32x4 v[4][4];
#pragma unroll
                    for (int rr = 0; rr < 4; ++rr) { const GAS f32x4* xr = (const GAS f32x4*)(x + (size_t)(m0 + rr) * DM) + lane;
#pragma unroll
                        for (int j = 0; j < 4; ++j) v[rr][j] = __builtin_nontemporal_load(xr + 64 * j); }
#pragma unroll
                    for (int rr = 0; rr < 4; ++rr) { float s = 0.f;
#pragma unroll
                        for (int j = 0; j < 4; ++j) s += (v[rr][j].x * v[rr][j].x + v[rr][j].y * v[rr][j].y) + (v[rr][j].z * v[rr][j].z + v[rr][j].w * v[rr][j].w);
                        s = wave_sum(s);
                        const float r = rsqrtf(s * (1.f / 1024.f) + pg8::RMS_EPS);
                        if (lane == 0) INV[m0 + rr] = 1.0f / r;
                        GAS unsigned long long* o8 = (GAS unsigned long long*)(XN + (size_t)(m0 + rr) * DM) + lane;
#pragma unroll
                        for (int j = 0; j < 4; ++j) o8[64 * j] = (unsigned long long)pk2(v[rr][j].x * r, v[rr][j].y * r) | ((unsigned long long)pk2(v[rr][j].z * r, v[rr][j].w * r) << 32); }
                } }
        }
        {
            { const float* p = args.in[1]; bf16* PB = (bf16*)(ws + WS_PB);
                const size_t NP = (size_t)M * PLE_DIM / 4, stride = (size_t)NGW * 64;
                for (size_t i0 = (size_t)(gw * 64 + lane); i0 < NP; i0 += 4 * stride) { f32x4 v[4];
#pragma unroll
                    for (int k = 0; k < 4; ++k) if (i0 + k * stride < NP) v[k] = __builtin_nontemporal_load((const GAS f32x4*)(p + (i0 + k * stride) * 4));
#pragma unroll
                    for (int k = 0; k < 4; ++k) if (i0 + k * stride < NP) *(GAS unsigned long long*)(PB + (i0 + k * stride) * 4) = (unsigned long long)pk2(v[k].x, v[k].y) | ((unsigned long long)pk2(v[k].z, v[k].w) << 32); } }
        }
        {
            {
                for (int i = bx * (NWAVES * 64) + tid; i < (int)(4 * MiB / 16); i += G * NWAVES * 64) ((GAS v4u*)(ws + WS_XBUF))[i] = (v4u){0u, 0u, 0u, 0u}; }
            {
                const int t = bx * (NWAVES * 64) + tid;
                if ((t & 3) == 0 && (t >> 2) < SEQ * 8) { const int i = t >> 2, pos = i >> 3, j = i & 7;
                    const float invs[8] = {(float)1.0, (float)0.19392274474868576, (float)0.03760603093086393, (float)0.007292664737217109, (float)0.001414213562373095, (float)0.0002742481756762073, (float)5.318295896944988e-05, (float)1.031338537721246e-05};
                    float inv = invs[0];
#pragma unroll
                    for (int k = 1; k < 8; ++k) inv = (j == k) ? invs[k] : inv;
                    const float ang = (float)pos * inv;
                    ROPE_C[i] = (float)cos((double)ang); ROPE_S[i] = (float)sin((double)ang); } }
        }
        }
    }
    SEAM(0);
    if (IN(1)) { pg8::Gemm g{XN, (const bf16*)(ws + WS_W1A), M, 2 * FFN, DM}; pg8::StaticOrder S; S.init(M, 2 * FFN, G, bx);
        pg8::EpiSwiglu E{(bf16*)(ws + WS_H)};
        pg8::gemm_phase<DM, pg8::EpiSwiglu, pg8::StaticOrder, true, true>(L + RING_OFF, g, S, E, wave);
        }
#ifdef PROBE_G2
    { xcd_barrier(bar);
        pg8::Gemm g{(const bf16*)(ws + WS_H), (const bf16*)(ws + WS_W2A), M, DM, FFN}; pg8::StaticOrder S; S.init(M, DM, G, bx);
        pg8::EpiSwigluT<2> E{(bf16*)(ws + WS_H)};
        pg8::gemm_phase<FFN, pg8::EpiSwigluT<2>, pg8::StaticOrder, true, true>(L + RING_OFF, g, S, E, wave); }
    { xcd_barrier(bar);
        pg8::Gemm g{(const bf16*)(ws + WS_H), (const bf16*)(ws + WS_W2A), M, DM, FFN}; pg8::StaticOrder S; S.init(M, DM, G, bx);
        pg8::EpiSwigluT<2> E{(bf16*)(ws + WS_H)};
        pg8::gemm_phase<FFN, pg8::EpiSwigluT<2>, pg8::StaticOrder, true, true>(L + RING_OFF, g, S, E, wave); }
#endif
#ifdef PROBE_G1
    { xcd_barrier(bar);
        pg8::Gemm g{XN, (const bf16*)(ws + WS_W1A), M, 2 * FFN, DM}; pg8::StaticOrder S; S.init(M, 2 * FFN, G, bx);
        pg8::EpiSwigluT<PROBE_G1 - 1> E{(bf16*)(ws + WS_H)};
        pg8::gemm_phase<DM, pg8::EpiSwigluT<PROBE_G1 - 1>, pg8::StaticOrder, true, true>(L + RING_OFF, g, S, E, wave); }
    { xcd_barrier(bar);
        pg8::Gemm g{XN, (const bf16*)(ws + WS_W1A), M, 2 * FFN, DM}; pg8::StaticOrder S; S.init(M, 2 * FFN, G, bx);
        pg8::EpiSwigluT<PROBE_G1 - 1> E{(bf16*)(ws + WS_H)};
        pg8::gemm_phase<DM, pg8::EpiSwigluT<PROBE_G1 - 1>, pg8::StaticOrder, true, true>(L + RING_OFF, g, S, E, wave); }
#endif
    SEAM(1);
    if (IN(2)) { const unsigned poison = (unsigned)__builtin_amdgcn_readfirstlane((int)(__hip_atomic_load(ctl + CW_TMO, RLX_AGENT) != 0u));
        pg8::Gemm g{(const bf16*)(ws + WS_H), (const bf16*)(ws + WS_W2A), M, DM, FFN};
#pragma nounroll
        for (int rd = 0; rd < 2; ++rd) { pg8::PanelSsq st{(unsigned*)(ws + WS_XBUF), (unsigned*)(ctl + CW_SEAM), (unsigned*)(ctl + CW_TMO), 0x700u}, st2{(unsigned*)(ws + WS_XBUF) + (size_t)4 * M * 4, (unsigned*)(ctl + CW_SEAM + 4 * SEAM_BANK), (unsigned*)(ctl + CW_TMO), 0x800u}; pg8::EpiRmsRes E{XN, INV, INV + M, args.in[5], 0.5f, st, st2, poison};
            pg8::RoundOrder S; S.so.init(M, DM, G, bx); S.round = rd;
            pg8::gemm_phase<FFN, pg8::EpiRmsRes, pg8::RoundOrder, false, true>(L + RING_OFF, g, S, E, wave); __syncthreads(); } }
    SEAM(2);
    if (IN(3)) { pg8::Gemm g{XN, (const bf16*)(ws + WS_WINA), M, 4096, DM}; pg8::StaticOrder S; S.init(M, 4096, G, bx);
        pg8::EpiRoute E{(bf16*)(ws + WS_AQ), (bf16*)(ws + WS_AKV), (bf16*)(ws + WS_MQK), (bf16*)(ws + WS_MV), (bf16*)(ws + WS_MO), (float*)(ws + WS_GATES), ROPE_C, ROPE_S, args.in[8]};
        pg8::gemm_phase<DM, pg8::EpiRoute, pg8::StaticOrder, true, true>(L + RING_OFF, g, S, E, wave); }
    SEAM(3);
    if (IN(4)) {
            const bf16* MQK = (const bf16*)(ws + WS_MQK); bf16* CQK = (bf16*)(ws + WS_CQK); const float* cw = args.in[9]; const float* cb = args.in[10];
            for (int it = bx * (NWAVES * 64) + tid; it < (M / 16) * 128; it += G * NWAVES * 64) {
                const int cg = it & 127, rb = it >> 7, c0 = cg * 8, r0 = rb * 16, s0 = r0 & (SEQ - 1);
                pg8::u32x4 raw[20];
#pragma unroll
                for (int i = 0; i < 20; ++i) { const int sp = s0 - 2 + i; raw[i] = (pg8::u32x4){0u, 0u, 0u, 0u}; if (sp >= 0 && sp < SEQ) raw[i] = __builtin_nontemporal_load((const pg8::u32x4*)(MQK + (size_t)(r0 - 2 + i) * 1024 + c0)); }
                float wgt[5][8], bias[8];
#pragma unroll
                for (int j = 0; j < 5; ++j) { const f32x4 a = *(const f32x4*)(cw + j * 1024 + c0), b = *(const f32x4*)(cw + j * 1024 + c0 + 4);
                    wgt[j][0] = a[0]; wgt[j][1] = a[1]; wgt[j][2] = a[2]; wgt[j][3] = a[3]; wgt[j][4] = b[0]; wgt[j][5] = b[1]; wgt[j][6] = b[2]; wgt[j][7] = b[3]; }
                { const f32x4 a = *(const f32x4*)(cb + c0), b = *(const f32x4*)(cb + c0 + 4); bias[0] = a[0]; bias[1] = a[1]; bias[2] = a[2]; bias[3] = a[3]; bias[4] = b[0]; bias[5] = b[1]; bias[6] = b[2]; bias[7] = b[3]; }
                const float osc = (c0 >= 512) ? 0.08838834764831845f : 1.0f;
#pragma unroll
                for (int o = 0; o < 16; ++o) { float acc8[8];
#pragma unroll
                    for (int e = 0; e < 8; ++e) acc8[e] = bias[e];
#pragma unroll
                    for (int j = 0; j < 5; ++j) { pg8::f32x4 a, b; pg8::unpack8(raw[o + j], a, b);
#pragma unroll
                        for (int e = 0; e < 4; ++e) { acc8[e] += a[e] * wgt[j][e]; acc8[4 + e] += b[e] * wgt[j][4 + e]; } }
                    pg8::f32x4 o0, o1;
#pragma unroll
                    for (int e = 0; e < 4; ++e) { o0[e] = acc8[e] * pg8::fsigmoid(acc8[e]) * osc; o1[e] = acc8[4 + e] * pg8::fsigmoid(acc8[4 + e]) * osc; }
                    *(pg8::u32x4*)(CQK + (size_t)(r0 + o) * 1024 + c0) = pg8::pack8(o0, o1); }
            }
    }
    SEAM(4);
    if (IN(5)) {
#ifdef PROBE_ML
        if (bx < 128) mix::mlstm_item3<PROBE_ML>(((((bx >> 3) >> 1) * 8 + (bx & 7)) << 1) | ((bx >> 3) & 1), L, (const bf16*)(ws + WS_CQK), (const bf16*)(ws + WS_MV), (const float*)(ws + WS_GATES), (bf16*)(ws + WS_HSF), (bf16*)(ws + WS_HSB), tid);
        xcd_barrier(bar);
#endif
#ifdef PROBE_AT
        if (bx >= 128) mix::attn_run(((bx - 128) & 7) * 16 + ((bx - 128) >> 3), G - 128, 1024, L, (const bf16*)(ws + WS_AQ), (const bf16*)(ws + WS_AKV), (bf16*)(ws + WS_T1), args.in[11], tid);
        xcd_barrier(bar);
#endif
        const int mitem = ((((bx >> 3) >> 1) * 8 + (bx & 7)) << 1) | ((bx >> 3) & 1);
        if (bx < 128) { mix::mlstm_item3(mitem, L, (const bf16*)(ws + WS_CQK), (const bf16*)(ws + WS_MV), (const float*)(ws + WS_GATES), (bf16*)(ws + WS_HSF), (bf16*)(ws + WS_HSB), tid);
            { const int grp = mitem >> 2, qtr = mitem & 3; gu32* cnt = ctl + CW_HMG + 64 * grp;
              VM_WAIT(); __syncthreads();
              if (tid == 0) { __builtin_amdgcn_fence(__ATOMIC_RELEASE, "agent"); VM_WAIT(); __hip_atomic_fetch_add(cnt, 1u, RLX_AGENT);
                  unsigned sp = 0; while (__hip_atomic_load(cnt, RLX_AGENT) < 4u) { __builtin_amdgcn_s_sleep(8); if (++sp > (1u << 22)) { __hip_atomic_store(ctl + CW_TMO, 1u, RLX_AGENT); break; } }
                  __builtin_amdgcn_fence(__ATOMIC_ACQUIRE, "agent"); VM_WAIT(); }
              __syncthreads();
              const bf16* HSF = (const bf16*)(ws + WS_HSF); const bf16* HSB = (const bf16*)(ws + WS_HSB); bf16* HM = (bf16*)(ws + WS_HM); const float* gn = args.in[12];
              const int hh = grp & 3; const size_t rb0 = (size_t)(grp >> 2) * SEQ + qtr * 1024 + wave * 128;
              const int hl = lane & 31, rsel = lane >> 5;
              const pg8::f32x4 gg0 = *(const pg8::f32x4*)(gn + hh * 256 + hl * 8), gg1 = *(const pg8::f32x4*)(gn + hh * 256 + hl * 8 + 4);
#pragma nounroll
              for (int r0 = 0; r0 < 128; r0 += 16) {
                  pg8::u32x4 qa[8], qb[8], qg[8];
#pragma unroll
                  for (int i = 0; i < 8; ++i) { const size_t o = (rb0 + r0 + 2 * i + rsel) * 1024 + hh * 256 + hl * 8;
                      qa[i] = __builtin_nontemporal_load((const pg8::u32x4*)(HSF + o)); qb[i] = __builtin_nontemporal_load((const pg8::u32x4*)(HSB + o)); qg[i] = __builtin_nontemporal_load((const pg8::u32x4*)(HM + o)); }
#pragma unroll
                  for (int i = 0; i < 8; ++i) { pg8::f32x4 a0, a1, b0, b1, g0, g1; pg8::unpack8(qa[i], a0, a1); pg8::unpack8(qb[i], b0, b1); pg8::unpack8(qg[i], g0, g1);
                      const pg8::f32x4 v0 = a0 + b0, v1 = a1 + b1;
                      float ss = ((v0[0] * v0[0] + v0[1] * v0[1]) + (v0[2] * v0[2] + v0[3] * v0[3])) + ((v1[0] * v1[0] + v1[1] * v1[1]) + (v1[2] * v1[2] + v1[3] * v1[3]));
#pragma unroll
                      for (int o = 1; o < 32; o <<= 1) ss += __shfl_xor(ss, o);
                      const float r = rsqrtf(ss * (1.f / 256.f) + pg8::RMS_EPS);
                      *(pg8::u32x4*)(HM + (rb0 + r0 + 2 * i + rsel) * 1024 + hh * 256 + hl * 8) = pg8::pack8(v0 * r * gg0 * g0, v1 * r * gg1 * g1); }
              } }
            pg8::Gemm g{XN, (const bf16*)(ws + WS_WINB), M, 2048, DM}; pg8::QueueOrder S; S.so.init(M, 2048, 1, 0); S.xlab = bx & 7; S.ctr = (unsigned*)(ctl + CW_G3BQ + 64 * (bx & 7)); S.limit = 1024; S.slot = (LAS int*)(L + 131072 + 12288); S.wave = wave;
            pg8::EpiSig E{(bf16*)args.out, (bf16*)args.out + (size_t)M * 1024};
            pg8::gemm_phase<DM, pg8::EpiSig, pg8::QueueOrder, true, true>(L + RING_OFF, g, S, E, wave); }
        if (bx >= 128) { mix::attn_run(((bx - 128) & 7) * 16 + ((bx - 128) >> 3), G - 128, 1024, L, (const bf16*)(ws + WS_AQ), (const bf16*)(ws + WS_AKV), (bf16*)(ws + WS_AQ), args.in[11], tid);
            pg8::Gemm g{XN, (const bf16*)(ws + WS_WINB), M, 2048, DM}; pg8::QueueOrder S; S.so.init(M, 2048, 1, 0); S.xlab = bx & 7; S.ctr = (unsigned*)(ctl + CW_G3BQ + 64 * (bx & 7)); S.limit = 1024; S.slot = (LAS int*)(L + 131072 + 12288); S.wave = wave;
            pg8::EpiSig E{(bf16*)args.out, (bf16*)args.out + (size_t)M * 1024};
            pg8::gemm_phase<DM, pg8::EpiSig, pg8::QueueOrder, true, true>(L + RING_OFF, g, S, E, wave); }
    }
    SEAM(5);
    if (IN(8)) {
        { pg8::Gemm g{(const bf16*)(ws + WS_AQ), (const bf16*)(ws + WS_WBA), M, DM, 512}; pg8::StaticOrder S; S.init(M, DM, G, bx);
          pg8::EpiMul<false> E{(bf16*)(ws + WS_T1), (const bf16*)args.out, nullptr};
          pg8::gemm_phase<512, pg8::EpiMul<false>, pg8::StaticOrder, true, true>(L + RING_OFF, g, S, E, wave); }
        VM_WAIT(); __syncthreads();
        { pg8::Gemm g{(const bf16*)(ws + WS_HM), (const bf16*)(ws + WS_WBM), M, DM, DM}; pg8::StaticOrder S; S.init(M, DM, G, bx);
          pg8::EpiMul<true> E{(bf16*)(ws + WS_MG), (const bf16*)args.out + (size_t)M * 1024, (const bf16*)(ws + WS_T1)};
          pg8::gemm_phase<DM, pg8::EpiMul<true>, pg8::StaticOrder, true, true>(L + RING_OFF, g, S, E, wave); } }
    SEAM(8);
    if (IN(9)) { const unsigned poison = (unsigned)__builtin_amdgcn_readfirstlane((int)(__hip_atomic_load(ctl + CW_TMO, RLX_AGENT) != 0u));
        pg8::Gemm g{(const bf16*)(ws + WS_MG), (const bf16*)(ws + WS_WOUT), M, DM, DM};
#pragma nounroll
        for (int rd = 0; rd < 2; ++rd) { pg8::PanelSsq st{(unsigned*)(ws + WS_XBUF) + (size_t)1 * M * 4, (unsigned*)(ctl + CW_SEAM + 1 * SEAM_BANK), (unsigned*)(ctl + CW_TMO), 0x740u}, st2{(unsigned*)(ws + WS_XBUF) + (size_t)5 * M * 4, (unsigned*)(ctl + CW_SEAM + 5 * SEAM_BANK), (unsigned*)(ctl + CW_TMO), 0x840u}; pg8::EpiRmsRes E{XN, INV + M, INV + 2 * M, args.in[16], 1.0f, st, st2, poison};
            pg8::RoundOrder S; S.so.init(M, DM, G, bx); S.round = rd;
            pg8::gemm_phase<DM, pg8::EpiRmsRes, pg8::RoundOrder, false, true>(L + RING_OFF, g, S, E, wave); __syncthreads(); } }
    SEAM(9);
    if (IN(10)) { pg8::Gemm g{XN, (const bf16*)(ws + WS_W1B), M, 2 * FFN, DM}; pg8::StaticOrder S; S.init(M, 2 * FFN, G, bx);
        pg8::EpiSwiglu E{(bf16*)(ws + WS_H)};
        pg8::gemm_phase<DM, pg8::EpiSwiglu, pg8::StaticOrder, true, true>(L + RING_OFF, g, S, E, wave); }
    SEAM(10);
    if (IN(11)) { const unsigned poison = (unsigned)__builtin_amdgcn_readfirstlane((int)(__hip_atomic_load(ctl + CW_TMO, RLX_AGENT) != 0u));
        pg8::Gemm g{(const bf16*)(ws + WS_H), (const bf16*)(ws + WS_W2B), M, DM, FFN};
#pragma nounroll
        for (int rd = 0; rd < 2; ++rd) { pg8::PanelSsq st{(unsigned*)(ws + WS_XBUF) + (size_t)2 * M * 4, (unsigned*)(ctl + CW_SEAM + 2 * SEAM_BANK), (unsigned*)(ctl + CW_TMO), 0x780u}, st2{(unsigned*)(ws + WS_XBUF) + (size_t)6 * M * 4, (unsigned*)(ctl + CW_SEAM + 6 * SEAM_BANK), (unsigned*)(ctl + CW_TMO), 0x880u}; pg8::EpiRmsRes E{XN, INV + 2 * M, INV + 3 * M, args.in[20], 0.5f, st, st2, poison};
            pg8::RoundOrder S; S.so.init(M, DM, G, bx); S.round = rd;
            pg8::gemm_phase<FFN, pg8::EpiRmsRes, pg8::RoundOrder, false, true>(L + RING_OFF, g, S, E, wave); __syncthreads(); } }
    SEAM(11);
    if (IN(12)) {
        { pg8::Gemm g{(const bf16*)(ws + WS_PB), (const bf16*)(ws + WS_WPP), M, DM, PLE_DIM}; pg8::StaticOrder S; S.init(M, DM, G, bx);
          pg8::EpiPlainNP E{(bf16*)(ws + WS_PR)};
          pg8::gemm_phase<PLE_DIM, pg8::EpiPlainNP, pg8::StaticOrder, true, true>(L + RING_OFF, g, S, E, wave); }
        VM_WAIT(); __syncthreads();
        const unsigned poison = (unsigned)__builtin_amdgcn_readfirstlane((int)(__hip_atomic_load(ctl + CW_TMO, RLX_AGENT) != 0u));
        pg8::Gemm g{XN, (const bf16*)(ws + WS_WPG), M, DM, DM};
#pragma nounroll
        for (int rd = 0; rd < 2; ++rd) { pg8::PanelSsq st{(unsigned*)(ws + WS_XBUF) + (size_t)3 * M * 4, (unsigned*)(ctl + CW_SEAM + 3 * SEAM_BANK), (unsigned*)(ctl + CW_TMO), 0x7c0u}; pg8::EpiPle E{XN, INV + 3 * M, args.out, (const bf16*)(ws + WS_PR), args.in[24], st, poison};
            pg8::RoundOrder S; S.so.init(M, DM, G, bx); S.round = rd;
            pg8::gemm_phase<DM, pg8::EpiPle, pg8::RoundOrder, false, true>(L + RING_OFF, g, S, E, wave); __syncthreads(); } }
#undef IN
#undef tid
#undef lane
#undef SEAM
}
extern "C" void kernel_launch(void* const* d_in, const int* in_sizes, int n_in, void* d_out, int out_size, void* d_ws, size_t ws_size, hipStream_t stream) {
    static int grid = 0;
    if (grid == 0) {
        if (n_in != 25 || in_sizes[0] != M * DM || out_size != M * DM || ws_size < WS_END) { fprintf(stderr, "kernel_launch: unexpected shapes (n_in %d, in0 %d, out %d, ws %zu)\n", n_in, n_in > 0 ? in_sizes[0] : -1, out_size, ws_size); grid = -1; return; }
        int dev = 0, cus = 0, per_cu = 0;
        if (hipGetDevice(&dev) != hipSuccess || hipDeviceGetAttribute(&cus, hipDeviceAttributeMultiprocessorCount, dev) != hipSuccess) { grid = -1; return; }
        if (hipFuncSetAttribute((const void*)mk_fwd, hipFuncAttributeMaxDynamicSharedMemorySize, LDS_BYTES) != hipSuccess) { fprintf(stderr, "kernel_launch: hipFuncSetAttribute failed\n"); grid = -1; return; }
        if (hipOccupancyMaxActiveBlocksPerMultiprocessor(&per_cu, (const void*)mk_fwd, NWAVES * 64, LDS_BYTES) != hipSuccess || per_cu < 1) { fprintf(stderr, "kernel_launch: occupancy query says %d\n", per_cu); per_cu = 1; }
        (void)hipGetLastError();
        grid = cus;
        if (grid != 256) fprintf(stderr, "kernel_launch: %d CUs; the fused epilogues need a 256-workgroup grid\n", grid);
    }
    if (grid < 0) return;
    (void)hipMemsetAsync((char*)d_ws + WS_CTL, 0, CTL_ZERO_BYTES, stream);
    Args a{};
    for (int i = 0; i < 25; ++i) a.in[i] = (const float*)d_in[i];
    a.out = (float*)d_out; a.ws = (unsigned char*)d_ws;
    a.ph_lo = 0; a.ph_hi = 13; a.li = 0;
    hipLaunchKernelGGL(mk_fwd, dim3(grid), dim3(NWAVES * 64), LDS_BYTES, stream, a);
}
```
